# Optimizing an MI355X kernel written in HIP

```python
import jax, jax.numpy as jnp
from jax import lax
import numpy as np

D_MODEL = 1024
BATCH = 2
SEQ = 8192
DEPTH = 4

GRID_W = 64
CTX_LEN = 256
CHUNK = 128
Q_BLOCK = 128
EPS = 1e-6
ROPE_THETA = 10000.0
N_MOD = 6

A_HEADS = 4
A_HEAD_DIM = 64
A_WIDTH = A_HEADS * A_HEAD_DIM
ATT_Q_HEADS = 8
ATT_KV_HEADS = 2
ATT_HEAD_DIM = 64
ATT_REP = ATT_Q_HEADS // ATT_KV_HEADS
ATT_WIDTH = ATT_Q_HEADS * ATT_HEAD_DIM
ATT_KV_WIDTH = ATT_KV_HEADS * ATT_HEAD_DIM
ATT_SCALE = ATT_HEAD_DIM ** -0.5
ROPE_AXIS_DIM = ATT_HEAD_DIM // 2
ROPE_AXIS_FREQS = ROPE_AXIS_DIM // 2
C_WIDTH = 256
D_MIX = A_WIDTH + ATT_WIDTH + C_WIDTH
D_FF = 2816

OFF_AU = 0
OFF_AV = OFF_AU + A_WIDTH
OFF_Q = OFF_AV + A_WIDTH
OFF_K = OFF_Q + ATT_WIDTH
OFF_V = OFF_K + ATT_KV_WIDTH
OFF_CB = OFF_V + ATT_KV_WIDTH
OFF_CC = OFF_CB + C_WIDTH
OFF_CH = OFF_CC + C_WIDTH
D_IN = OFF_CH + C_WIDTH

kernel_name = "hybrid_parallel_heads_diffusion_trunk"


def rms_norm(x, g):
    xf = x.astype(jnp.float32)
    y = xf * lax.rsqrt(jnp.mean(xf * xf, axis=-1, keepdims=True) + EPS)
    return (y * g.astype(jnp.float32)).astype(x.dtype)


def layer_norm_plain(x):
    xf = x.astype(jnp.float32)
    mu = jnp.mean(xf, axis=-1, keepdims=True)
    xc = xf - mu
    var = jnp.mean(xc * xc, axis=-1, keepdims=True)
    return (xc * lax.rsqrt(var + EPS)).astype(x.dtype)


def modulate(h, shift, scale):
    return h * (1 + scale) + shift


def dwconv3(x, w):
    xp = jnp.pad(x, ((0, 0), (1, 1), (0, 0)))
    return xp[:, :-2] * w[0] + xp[:, 1:-1] * w[1] + xp[:, 2:] * w[2]


def axial_rope_tables(n):
    rows = n // GRID_W
    row = jnp.repeat(jnp.arange(rows), GRID_W).astype(jnp.float32)
    col = jnp.tile(jnp.arange(GRID_W), rows).astype(jnp.float32)
    inv = ROPE_THETA ** (-2.0 * jnp.arange(ROPE_AXIS_FREQS, dtype=jnp.float32) / ROPE_AXIS_DIM)
    ang = jnp.stack([row[:, None] * inv, col[:, None] * inv], axis=1)
    return jnp.cos(ang), jnp.sin(ang)


def apply_rope(x, cos, sin):
    b, n, h, d = x.shape
    xr = x.astype(jnp.float32).reshape(b, n, h, 2, 2, ROPE_AXIS_FREQS)
    x1, x2 = xr[..., 0, :], xr[..., 1, :]
    cs, sn = cos[None, :, None], sin[None, :, None]
    out = jnp.stack([x1 * cs - x2 * sn, x2 * cs + x1 * sn], axis=-2)
    return out.reshape(b, n, h, d).astype(x.dtype)


def chunk_gmlp(u, v, w_s, b_s):
    b, n, _ = u.shape
    u = jax.nn.gelu(u)
    v = layer_norm_plain(jax.nn.gelu(v).reshape(b, n // CHUNK, CHUNK, A_HEADS, A_HEAD_DIM))
    mixed = jnp.einsum('hpq,bcqhd->bcphd', w_s, v) + b_s.T[None, None, :, :, None]
    return u * mixed.reshape(b, n, A_WIDTH)


def short_gated_conv(proj, conv_w):
    return proj[..., OFF_CB:OFF_CC] * dwconv3(proj[..., OFF_CC:OFF_CH] * proj[..., OFF_CH:D_IN], conv_w)


def q_heads(proj, q_g):
    b, n, _ = proj.shape
    return rms_norm(proj[..., OFF_Q:OFF_K].reshape(b, n, ATT_Q_HEADS, ATT_HEAD_DIM), q_g)


def kv_heads(kv_cols, k_g):
    b, n, _ = kv_cols.shape
    k = rms_norm(kv_cols[..., :ATT_KV_WIDTH].reshape(b, n, ATT_KV_HEADS, ATT_HEAD_DIM), k_g)
    v = kv_cols[..., ATT_KV_WIDTH:].reshape(b, n, ATT_KV_HEADS, ATT_HEAD_DIM)
    return k, v


def latent_attention(q, k_lat, v_lat, k_ctx, v_ctx):
    b, n = q.shape[:2]
    keys = jnp.concatenate([k_ctx, k_lat], axis=1)
    vals = jnp.concatenate([v_ctx, v_lat], axis=1)
    nb = n // Q_BLOCK
    qb = q.reshape(b, nb, Q_BLOCK, ATT_KV_HEADS, ATT_REP, ATT_HEAD_DIM).transpose(1, 0, 2, 3, 4, 5)

    def block(qi):
        s = jnp.einsum('bqgrd,bkgd->bgrqk', qi, keys, preferred_element_type=jnp.float32) * ATT_SCALE
        p = jax.nn.softmax(s, axis=-1).astype(vals.dtype)
        return jnp.einsum('bgrqk,bkgd->bqgrd', p, vals)

    o = lax.map(block, qb)
    return o.transpose(1, 0, 2, 3, 4, 5).reshape(b, n, ATT_WIDTH)


def context_attention(q, k, v):
    b, m = q.shape[:2]
    qg = q.reshape(b, m, ATT_KV_HEADS, ATT_REP, ATT_HEAD_DIM)
    s = jnp.einsum('bqgrd,bkgd->bgrqk', qg, k, preferred_element_type=jnp.float32) * ATT_SCALE
    p = jax.nn.softmax(s, axis=-1).astype(v.dtype)
    return jnp.einsum('bgrqk,bkgd->bqgrd', p, v).reshape(b, m, ATT_WIDTH)


def conv_ffn(h, w_up, w_conv, w_down):
    up = dwconv3(h @ w_up, w_conv)
    a, g = jnp.split(up, 2, axis=-1)
    return (jax.nn.silu(g) * a) @ w_down


def setup_inputs(seed: int = 0) -> dict:
    key = jax.random.key(seed)
    ks = jax.random.split(key, 20)
    f32 = jnp.float32
    nrm = lambda k, shape, s: jax.random.normal(k, shape, f32) * s
    return {
        "x": nrm(ks[0], (BATCH, SEQ, D_MODEL), 1.0),
        "c": nrm(ks[1], (BATCH, D_MODEL), 1.0),
        "ctx": nrm(ks[2], (BATCH, CTX_LEN, D_MODEL), 1.0),
        "c_ctx": nrm(ks[3], (D_MODEL,), 1.0),
        "w_mod": nrm(ks[4], (DEPTH, D_MODEL, N_MOD * D_MODEL), 0.5 * D_MODEL ** -0.5),
        "b_mod": nrm(ks[5], (DEPTH, N_MOD * D_MODEL), 0.02),
        "norm1_g": 1.0 + nrm(ks[6], (DEPTH, D_MODEL), 0.02),
        "w_in": nrm(ks[7], (DEPTH, D_MODEL, D_IN), D_MODEL ** -0.5),
        "q_norm_g": 1.0 + nrm(ks[8], (DEPTH, ATT_HEAD_DIM), 0.02),
        "k_norm_g": 1.0 + nrm(ks[9], (DEPTH, ATT_HEAD_DIM), 0.02),
        "gmlp_w": nrm(ks[10], (DEPTH, A_HEADS, CHUNK, CHUNK), CHUNK ** -0.5),
        "gmlp_b": 1.0 + nrm(ks[11], (DEPTH, A_HEADS, CHUNK), 0.02),
        "conv_c_w": nrm(ks[12], (DEPTH, 3, C_WIDTH), 3 ** -0.5),
        "w_out": nrm(ks[13], (DEPTH, D_MIX, D_MODEL), D_MIX ** -0.5),
        "norm2_g": 1.0 + nrm(ks[14], (DEPTH, D_MODEL), 0.02),
        "ffn_up": nrm(ks[15], (DEPTH, D_MODEL, 2 * D_FF), D_MODEL ** -0.5),
        "ffn_conv_w": nrm(ks[16], (DEPTH, 3, 2 * D_FF), 3 ** -0.5),
        "ffn_down": nrm(ks[17], (DEPTH, D_FF, D_MODEL), D_FF ** -0.5),
        "final_g": 1.0 + nrm(ks[18], (D_MODEL,), 0.02),
    }


def reference(x, c, ctx, c_ctx, w_mod, b_mod, norm1_g, w_in, q_norm_g, k_norm_g, gmlp_w, gmlp_b,
              conv_c_w, w_out, norm2_g, ffn_up, ffn_conv_w, ffn_down, final_g):
    b, n, d = x.shape
    cos, sin = axial_rope_tables(n)
    silu_c = jax.nn.silu(c)
    silu_cc = jax.nn.silu(c_ctx)
    xc = ctx
    for l in range(DEPTH):
        last = l == DEPTH - 1
        mod = (silu_c @ w_mod[l] + b_mod[l]).reshape(b, N_MOD, 1, d)
        mod_c = (silu_cc @ w_mod[l] + b_mod[l]).reshape(N_MOD, d)
        sh1, sc1, g1, sh2, sc2, g2 = [mod[:, i] for i in range(N_MOD)]
        csh1, csc1, cg1, csh2, csc2, cg2 = [mod_c[i] for i in range(N_MOD)]

        hc = modulate(rms_norm(xc, norm1_g[l]), csh1, csc1)
        if last:
            k_c, v_c = kv_heads(hc @ w_in[l][:, OFF_K:OFF_CB], k_norm_g[l])
        else:
            proj_c = hc @ w_in[l]
            k_c, v_c = kv_heads(proj_c[..., OFF_K:OFF_CB], k_norm_g[l])
            a_c = chunk_gmlp(proj_c[..., OFF_AU:OFF_AV], proj_c[..., OFF_AV:OFF_Q], gmlp_w[l], gmlp_b[l])
            att_c = context_attention(q_heads(proj_c, q_norm_g[l]), k_c, v_c)
            cm_c = short_gated_conv(proj_c, conv_c_w[l])
            mix_c = jnp.concatenate([a_c, att_c, cm_c], axis=-1) @ w_out[l]

        h = modulate(rms_norm(x, norm1_g[l]), sh1, sc1)
        proj = h @ w_in[l]
        q = apply_rope(q_heads(proj, q_norm_g[l]), cos, sin)
        k, v = kv_heads(proj[..., OFF_K:OFF_CB], k_norm_g[l])
        k = apply_rope(k, cos, sin)
        att = latent_attention(q, k, v, k_c, v_c)
        a = chunk_gmlp(proj[..., OFF_AU:OFF_AV], proj[..., OFF_AV:OFF_Q], gmlp_w[l], gmlp_b[l])
        cm = short_gated_conv(proj, conv_c_w[l])
        x = x + g1 * (jnp.concatenate([a, att, cm], axis=-1) @ w_out[l])
        x = x + g2 * conv_ffn(modulate(rms_norm(x, norm2_g[l]), sh2, sc2), ffn_up[l], ffn_conv_w[l], ffn_down[l])

        if not last:
            xc = xc + cg1 * mix_c
            xc = xc + cg2 * conv_ffn(modulate(rms_norm(xc, norm2_g[l]), csh2, csc2), ffn_up[l], ffn_conv_w[l], ffn_down[l])
    return rms_norm(x, final_g)
```

```cpp
#include <hip/hip_runtime.h>
#include <cstdio>
#include <cstdint>
namespace pg8 {
#define PG8_LAS __attribute__((address_space(3)))
typedef unsigned short bf16_t;
typedef short bf16x8 __attribute__((ext_vector_type(8)));
typedef float f32x4 __attribute__((ext_vector_type(4)));
typedef unsigned u32x4 __attribute__((ext_vector_type(4)));
constexpr int BM = 256, BK = 64, HALF = 128, HTB = HALF * BK * 2  , STAGE_BYTES = 8 * HTB, NXCD = 8, WGM = 8;

__host__ __device__ __forceinline__ int lds_byte(int r, int c) { const int st = (r >> 4) * 2 + (c >> 5), rr = r & 15, cc = c & 31, ob = rr * 64 + cc * 2; return st * 1024 + (ob ^ (((ob >> 9) & 1) << 5)); }
__host__ __device__ __forceinline__ void stage_rc(int b, int& R, int& C) { const int st = b / 1024, sb = b % 1024, swz = sb ^ (((sb >> 9) & 1) << 5); R = (st >> 1) * 16 + swz / 64; C = (st & 1) * 32 + (swz % 64) / 2; }
__host__ __device__ __forceinline__ int perm32(int rho) { const int n = rho >> 4, i = rho & 15; return 8 * (i >> 2) + 4 * n + (i & 3); }

__host__ __device__ __forceinline__ size_t wt_off(int P, int k, int nt, bool perm) {
    const int p = P & 127, x = p & 31, R = perm ? ((p & ~31) + 16 * ((x >> 2) & 1) + 4 * (x >> 3) + (x & 3)) : p;
    return ((size_t)(((P >> 8) * nt + (k >> 6)) * 2 + ((P >> 7) & 1)) * 16384 + (size_t)lds_byte(R, k & 63)) >> 1;
}
struct Unit { int pm, pn; };
struct Gemm { const bf16_t* A; const bf16_t* Bt; int M, N, K; };

struct StaticOrder {
    int nM, nN, nwg, G, c;
    __host__ __device__ __forceinline__ void init(int M, int N, int G_, int c_) { nM = M / BM; nN = N / BM; nwg = nM * nN; G = G_; c = c_; }
    __host__ __device__ __forceinline__ bool next(int i, Unit& u) const {
        const long L = (long)i * G + c; if (L >= nwg) return false;
        int wgid = (int)L; { const int q = nwg / NXCD, r = nwg % NXCD, xcd = wgid % NXCD, off = wgid / NXCD; wgid = (xcd < r ? xcd * (q + 1) : r * (q + 1) + (xcd - r) * q) + off; }
        const int nig = WGM * nN, gid = wgid / nig, fm = gid * WGM, gsz = (nM - fm) < WGM ? (nM - fm) : WGM;
        u.pm = fm + ((wgid % nig) % gsz); u.pn = (wgid % nig) / gsz; return true;
    }
    __device__ __forceinline__ void a_ready(const Unit&) const {}
    __device__ __forceinline__ void done(const Unit&) const {}
};

__device__ __forceinline__ unsigned cvt_pk_bf16(float lo, float hi) { unsigned r; asm volatile("v_cvt_pk_bf16_f32 %0, %1, %2" : "=v"(r) : "v"(lo), "v"(hi)); return r; }
typedef float f32x2 __attribute__((ext_vector_type(2)));
__device__ __forceinline__ f32x2 gelu_pk(f32x2 v) {
    const f32x2 av = __builtin_elementwise_abs(v), d = av * 0.2316418882f + 1.0f;
    f32x2 t; t.x = __builtin_amdgcn_rcpf(d.x); t.y = __builtin_amdgcn_rcpf(d.y);
    f32x2 q = t * 0.5307027145f + (-0.7265760135f); q = q * t + 0.7107068705f; q = q * t + (-0.142248368f); q = q * t + 0.127414796f; q = q * t;
    const f32x2 s = (v * v) * (-0.72134752044f);
    f32x2 e; e.x = __builtin_amdgcn_exp2f(s.x); e.y = __builtin_amdgcn_exp2f(s.y);
    const f32x2 m = v * (q * e), r = v - m;
    f32x2 o; o.x = v.x < 0.f ? m.x : r.x; o.y = v.y < 0.f ? m.y : r.y; return o;
}

template <int ACT  > struct EpiBf16 {
    static constexpr bool PERM = true, AFTER_DRAIN = false, ROWPERM = false; static_assert(ACT == 0 || ACT == 1, "EpiBf16: ACT is 0 (none) or 1 (gelu_pk)");
    bf16_t* O; int ldc; const float* bias; int split_cols; size_t split_stride; float scale0;
    __device__ __forceinline__ void operator()(const f32x4 (&acc)[2][2][4][2], const Unit& u, int wr, int wc, int fr, int fq) const {
        const int row0 = u.pm * BM + wr * 64 + fr; int colt = u.pn * BM; bf16_t* base = O;
        float sc = 1.f; if (split_cols) { const int t = colt / split_cols; base += (size_t)t * split_stride; colt -= t * split_cols; if (t == 0) sc = scale0; }
        const int col0 = colt + wc * 32 + 8 * fq, bcol0 = u.pn * BM + wc * 32 + 8 * fq;
        f32x4 bv[2][2];
#pragma unroll
        for (int bj = 0; bj < 2; ++bj)
#pragma unroll
            for (int n = 0; n < 2; ++n) bv[bj][n] = bias ? *(const f32x4*)(bias + bcol0 + bj * HALF + 4 * n) : (f32x4){0.f, 0.f, 0.f, 0.f};
#pragma unroll
        for (int ai = 0; ai < 2; ++ai)
#pragma unroll
            for (int m = 0; m < 4; ++m) { bf16_t* rowp = base + (size_t)(row0 + ai * HALF + m * 16) * ldc + col0;
#pragma unroll
                for (int bj = 0; bj < 2; ++bj) { f32x4 v0 = acc[ai][bj][m][0] + bv[bj][0], v1 = acc[ai][bj][m][1] + bv[bj][1];
                    if (ACT == 1) { f32x2 a = gelu_pk((f32x2){v0[0], v0[1]}), b = gelu_pk((f32x2){v0[2], v0[3]}), c = gelu_pk((f32x2){v1[0], v1[1]}), d = gelu_pk((f32x2){v1[2], v1[3]});
                        v0 = (f32x4){a.x, a.y, b.x, b.y}; v1 = (f32x4){c.x, c.y, d.x, d.y}; }
                    v0 = v0 * sc; v1 = v1 * sc; u32x4 w; w.x = cvt_pk_bf16(v0[0], v0[1]); w.y = cvt_pk_bf16(v0[2], v0[3]); w.z = cvt_pk_bf16(v1[0], v1[1]); w.w = cvt_pk_bf16(v1[2], v1[3]);
                    *(u32x4*)(rowp + bj * HALF) = w; } }
    }
};

template <class Epi, class Sched, bool ALIGN_EPI = false, bool SP2 = false>
__device__ __forceinline__ void gemm_phase(PG8_LAS unsigned char* lds, const Gemm g, const Sched& S, const Epi& E) {
    int tid_ = threadIdx.x; asm volatile("" : "+v"(tid_));
    const int tid = tid_, wid = __builtin_amdgcn_readfirstlane(tid >> 6), lane = tid & 63, wr = wid >> 2, wc = wid & 3, fr = lane & 15, fq = lane >> 4;
    const int K = g.K, nt = K / BK;
    unsigned voffA, voffB;
    { int R, C; stage_rc(tid * 16, R, C); const int Rb = Epi::PERM ? ((R & ~31) + perm32(R & 31)) : R; const int Ra = Epi::ROWPERM ? (8 * (R & 15) + ((R >> 4) & 3)) : R;
        voffA = (unsigned)(Ra * K + C) * 2u; voffB = (unsigned)tid * 16u; (void)Rb; }
    const size_t rstepB = 8192, rstepA = Epi::ROWPERM ? (size_t)128 * K * 2 : (size_t)64 * K * 2;
    const size_t kstep = (size_t)(BK * 2);
    const size_t hstep = (size_t)HALF * K * 2; const size_t hstepA = Epi::ROWPERM ? (size_t)4 * K * 2 : hstep;
    const size_t tstep = 2 * hstep;
    const size_t hstepB = 16384, kstepB = 32768, tstepB = (size_t)nt * 32768;
    const unsigned ldsw = (unsigned)wid * 1024u;
    const int aoff = lds_byte(wr * 64 + fr, fq * 8), boff = lds_byte(wc * 32 + fr, fq * 8);
#define PG8_SA(b, h) (((b) * 2 + (h)) * HTB)
#define PG8_SB(b, h) ((4 + (b) * 2 + (h)) * HTB)
#define PG8_STAGE(bufoff, gbase, voff, rstep64) do { _Pragma("unroll") for (int _i = 0; _i < 2; ++_i) \
        __builtin_amdgcn_global_load_lds((const unsigned*)((const char*)(gbase) + (size_t)_i * rstep64 + (voff)), (PG8_LAS unsigned*)(lds + (bufoff) + ldsw + _i * 8192), 16, 0, 0); } while (0)
#define PG8_LDA(dst, b, h) do { _Pragma("unroll") for (int m = 0; m < 4; ++m) _Pragma("unroll") for (int k = 0; k < 2; ++k) dst[m][k] = *(const PG8_LAS bf16x8*)(lds + PG8_SA(b, h) + aoff + m * 2048 + k * 1024); } while (0)
#define PG8_LDB(dst, b, h) do { _Pragma("unroll") for (int n = 0; n < 2; ++n) _Pragma("unroll") for (int k = 0; k < 2; ++k) dst[n][k] = *(const PG8_LAS bf16x8*)(lds + PG8_SB(b, h) + boff + n * 2048 + k * 1024); } while (0)
#define PG8_MMA(ai, bj, At, Bt) do { __builtin_amdgcn_s_setprio(1); _Pragma("unroll") for (int m = 0; m < 4; ++m) _Pragma("unroll") for (int n = 0; n < 2; ++n) _Pragma("unroll") for (int k = 0; k < 2; ++k) \
        acc[ai][bj][m][n] = __builtin_amdgcn_mfma_f32_16x16x32_bf16(Bt[n][k], At[m][k], acc[ai][bj][m][n], 0, 0, 0); __builtin_amdgcn_s_setprio(0); } while (0)
#define PG8_WAIT_V(n) asm volatile("s_waitcnt vmcnt(" #n ")" ::: "memory")
#define PG8_WAIT_L(n) asm volatile("s_waitcnt lgkmcnt(" #n ")" ::: "memory")
#define PG8_BAR __builtin_amdgcn_s_barrier()
#define PG8_SCHED __builtin_amdgcn_sched_barrier(0)
    Unit cur, nxt; int ui = 0;
    if (!S.next(0, cur)) return;
    f32x4 acc[2][2][4][2];
#pragma unroll
    for (int a = 0; a < 2; ++a)
#pragma unroll
        for (int b = 0; b < 2; ++b)
#pragma unroll
            for (int m = 0; m < 4; ++m)
#pragma unroll
                for (int n = 0; n < 2; ++n) acc[a][b][m][n] = (f32x4){0.f, 0.f, 0.f, 0.f};
    bf16x8 At[4][2], B0[2][2], B1[2][2];
    const char* cA = (const char*)g.A + (size_t)cur.pm * tstep; const char* cB = (const char*)g.Bt + (size_t)cur.pn * tstepB;
    S.a_ready(cur);
    if constexpr (SP2) {
        PG8_STAGE(PG8_SB(0, 0), cB, voffB, rstepB); PG8_STAGE(PG8_SB(0, 1), cB + hstepB, voffB, rstepB); PG8_STAGE(PG8_SA(0, 0), cA, voffA, rstepA); PG8_STAGE(PG8_SA(0, 1), cA + hstepA, voffA, rstepA);
        if (wr == 1) PG8_BAR;
        PG8_WAIT_V(2); PG8_BAR;
        PG8_STAGE(PG8_SB(1, 0), cB + kstepB, voffB, rstepB); PG8_STAGE(PG8_SA(1, 0), cA + kstep, voffA, rstepA); PG8_STAGE(PG8_SB(1, 1), cB + hstepB + kstepB, voffB, rstepB);
        PG8_WAIT_V(6); PG8_BAR;
    } else {
        PG8_STAGE(PG8_SB(0, 0), cB, voffB, rstepB); PG8_STAGE(PG8_SA(0, 0), cA, voffA, rstepA); PG8_STAGE(PG8_SB(0, 1), cB + hstepB, voffB, rstepB); PG8_STAGE(PG8_SA(0, 1), cA + hstepA, voffA, rstepA);
        if (wr == 1) PG8_BAR;
        PG8_WAIT_V(4); PG8_BAR;
        PG8_STAGE(PG8_SB(1, 0), cB + kstepB, voffB, rstepB); PG8_STAGE(PG8_SA(1, 0), cA + kstep, voffA, rstepA); PG8_STAGE(PG8_SB(1, 1), cB + hstepB + kstepB, voffB, rstepB);
        PG8_WAIT_V(6); PG8_BAR;
    }
    for (;;) {
        const bool has_next = S.next(ui + 1, nxt);
        const char* nA = has_next ? (const char*)g.A + (size_t)nxt.pm * tstep : cA; const char* nB = has_next ? (const char*)g.Bt + (size_t)nxt.pn * tstepB : cB;
        for (int t = 0; t < nt; t += 2) {
            const bool last = (t == nt - 2);
            const char* a1 = cA + (size_t)(t + 1) * kstep;
            const char* a2 = last ? nA : cA + (size_t)(t + 2) * kstep; const char* b2 = last ? nB : cB + (size_t)(t + 2) * kstepB;
            const char* a3 = a2 + kstep; const char* b3 = b2 + kstepB;
            if (last && has_next) S.a_ready(nxt);
            if constexpr (SP2) {
            PG8_LDB(B0, 0, 0); PG8_LDB(B1, 0, 1); PG8_SCHED; PG8_LDA(At, 0, 0); PG8_STAGE(PG8_SA(1, 1), a1 + hstepA, voffA, rstepA);
            PG8_WAIT_V(8); PG8_WAIT_L(0); PG8_BAR; PG8_MMA(0, 0, At, B0); PG8_MMA(0, 1, At, B1); PG8_BAR; PG8_SCHED;
            PG8_LDA(At, 0, 1); PG8_STAGE(PG8_SB(0, 0), b2, voffB, rstepB); PG8_STAGE(PG8_SB(0, 1), b2 + hstepB, voffB, rstepB); PG8_STAGE(PG8_SA(0, 0), a2, voffA, rstepA);
            PG8_WAIT_V(8); PG8_WAIT_L(0); PG8_BAR; PG8_MMA(1, 0, At, B0); PG8_MMA(1, 1, At, B1); PG8_BAR; PG8_SCHED;
            PG8_LDB(B0, 1, 0); PG8_LDB(B1, 1, 1); PG8_SCHED; PG8_LDA(At, 1, 0); PG8_STAGE(PG8_SA(0, 1), a2 + hstepA, voffA, rstepA);
            PG8_WAIT_V(8); PG8_WAIT_L(0); PG8_BAR; PG8_MMA(0, 0, At, B0); PG8_MMA(0, 1, At, B1); PG8_BAR; PG8_SCHED;
            PG8_LDA(At, 1, 1); PG8_STAGE(PG8_SB(1, 0), b3, voffB, rstepB); PG8_STAGE(PG8_SB(1, 1), b3 + hstepB, voffB, rstepB); PG8_STAGE(PG8_SA(1, 0), a3, voffA, rstepA);
            PG8_WAIT_V(8); PG8_WAIT_L(0); PG8_BAR; PG8_MMA(1, 0, At, B0); PG8_MMA(1, 1, At, B1); PG8_BAR; PG8_SCHED;
            } else {
            PG8_LDB(B0, 0, 0); PG8_SCHED; PG8_LDA(At, 0, 0); PG8_STAGE(PG8_SA(1, 1), a1 + hstepA, voffA, rstepA);
            PG8_WAIT_L(8); PG8_BAR; PG8_WAIT_L(0); PG8_MMA(0, 0, At, B0); PG8_BAR; PG8_SCHED;
            PG8_LDB(B1, 0, 1); PG8_STAGE(PG8_SB(0, 0), b2, voffB, rstepB);
            PG8_BAR; PG8_WAIT_L(0); PG8_MMA(0, 1, At, B1); PG8_BAR;
            PG8_LDA(At, 0, 1); PG8_STAGE(PG8_SA(0, 0), a2, voffA, rstepA);
            PG8_BAR; PG8_WAIT_L(0); PG8_MMA(1, 0, At, B0); PG8_BAR; PG8_SCHED;
            PG8_STAGE(PG8_SB(0, 1), b2 + hstepB, voffB, rstepB);
            PG8_WAIT_V(6); PG8_BAR; PG8_MMA(1, 1, At, B1); PG8_BAR;
            PG8_LDB(B0, 1, 0); PG8_SCHED; PG8_LDA(At, 1, 0); PG8_STAGE(PG8_SA(0, 1), a2 + hstepA, voffA, rstepA);
            PG8_WAIT_L(8); PG8_BAR; PG8_WAIT_L(0); PG8_MMA(0, 0, At, B0); PG8_BAR; PG8_SCHED;
            PG8_LDB(B1, 1, 1); PG8_STAGE(PG8_SB(1, 0), b3, voffB, rstepB);
            PG8_BAR; PG8_WAIT_L(0); PG8_MMA(0, 1, At, B1); PG8_BAR;
            PG8_LDA(At, 1, 1); PG8_STAGE(PG8_SA(1, 0), a3, voffA, rstepA);
            PG8_BAR; PG8_WAIT_L(0); PG8_MMA(1, 0, At, B0); PG8_BAR; PG8_SCHED;
            PG8_STAGE(PG8_SB(1, 1), b3 + hstepB, voffB, rstepB);
            PG8_WAIT_V(6); PG8_BAR; PG8_MMA(1, 1, At, B1); PG8_BAR;
            }
        }
        if constexpr (ALIGN_EPI) { if (wr == 0) PG8_BAR; }
        if constexpr (!Epi::AFTER_DRAIN) { E(acc, cur, wr, wc, fr, fq); S.done(cur); }
        if (!has_next) break;
#pragma unroll
        for (int a = 0; a < 2; ++a)
#pragma unroll
            for (int b = 0; b < 2; ++b)
#pragma unroll
                for (int m = 0; m < 4; ++m)
#pragma unroll
                    for (int n = 0; n < 2; ++n) acc[a][b][m][n] = (f32x4){0.f, 0.f, 0.f, 0.f};
        cur = nxt; cA = nA; cB = nB; ++ui;
        if constexpr (ALIGN_EPI) { if (wr == 1) PG8_BAR; }
    }
    PG8_WAIT_V(0);
    if constexpr (!ALIGN_EPI) { if (wr == 0) PG8_BAR; }
    PG8_BAR;
    if constexpr (Epi::AFTER_DRAIN) { E.fused(acc, cur, wr, wc, fr, fq, lds, wid, lane); S.done(cur); }
#undef PG8_SA
#undef PG8_SB
#undef PG8_STAGE
#undef PG8_LDA
#undef PG8_LDB
#undef PG8_MMA
#undef PG8_WAIT_V
#undef PG8_WAIT_L
#undef PG8_BAR
#undef PG8_SCHED
}
}

#ifndef PG8_SP2
#define PG8_SP2 true
#endif
#ifndef PG8_ALIGN
#define PG8_ALIGN true
#endif
#include <hip/hip_bf16.h>
#include <cmath>
namespace attn_body {
using bf16=__hip_bfloat16;
using bf16x8=__attribute__((ext_vector_type(8)))short;
using s16x4=__attribute__((ext_vector_type(4)))short;
using f32x16=__attribute__((ext_vector_type(16)))float;
using u32x4=__attribute__((ext_vector_type(4)))unsigned;
constexpr int D=64;
constexpr int NW=8,QBLK=32,QB=QBLK*NW,KVBLK=64;
__device__ __forceinline__ int crow(int r,int hi){return (r&3)+8*(r>>2)+4*hi;}
#define SBAR() __builtin_amdgcn_sched_barrier(0)
__device__ __forceinline__ void cmask(f32x16&p0,f32x16&p1,int jb,int qrel,int hi){
  const float NEG=-INFINITY; int kb=64*jb+4*hi;
  #pragma unroll
  for(int r=0;r<16;++r){int kv=kb+(r&3)+8*(r>>2); if(kv>qrel)p0[r]=NEG; if(kv+32>qrel)p1[r]=NEG;}
}

constexpr int NSLOT=3, SLOTB=8192;
constexpr int LDS_K=0, LDS_V=NSLOT*SLOTB, LDS_WS=2*NSLOT*SLOTB, LDS_OST=LDS_WS+NW*64*4, LDS_BYTES=LDS_OST+NW*4096;
constexpr float C2=0.125f*1.4426950408889634f;
__device__ __forceinline__ void glds16(const void*gsrc,unsigned lds_dst){unsigned keep;
  asm volatile("s_mov_b32 %0, m0\n\ts_mov_b32 m0, %2\n\ts_nop 0\n\tglobal_load_lds_dwordx4 %1, off\n\ts_mov_b32 m0, %0":"=&s"(keep):"v"(gsrc),"s"(lds_dst):"memory");}
__device__ __forceinline__ float max3f(float a,float b,float c){float r;asm("v_max3_f32 %0, %1, %2, %3":"=v"(r):"v"(a),"v"(b),"v"(c));return r;}
__device__ __forceinline__ float max2f(float a,float b){float r;asm("v_max_f32_e32 %0, %1, %2":"=v"(r):"v"(a),"v"(b));return r;}
__device__ __forceinline__ float fadd_s(float a,float b){float r;asm("v_add_f32_e32 %0, %1, %2":"=v"(r):"v"(a),"v"(b));return r;}
__device__ __forceinline__ float fsub_s(float a,float b){float r;asm("v_sub_f32_e32 %0, %1, %2":"=v"(r):"v"(a),"v"(b));return r;}
typedef float f32x2_t __attribute__((ext_vector_type(2))); typedef __bf16 bf16x2_t __attribute__((ext_vector_type(2)));
__device__ __forceinline__ unsigned cvtpk_s(float lo,float hi){f32x2_t v={lo,hi};bf16x2_t b=__builtin_convertvector(v,bf16x2_t);return __builtin_bit_cast(unsigned,b);}
#define WAIT_BAR(N) asm volatile("s_waitcnt vmcnt(" #N ") lgkmcnt(0)\n\ts_barrier":::"memory")

__device__ __forceinline__ void qkt(f32x16&p0,f32x16&p1,const char*Kslot,const bf16x8*qr,const f32x16&negm,int r32,int hi){
  const char*kb=Kslot+hi*1024+r32*16;
  #pragma unroll
  for(int d0=0;d0<4;++d0){
    const bf16x8 b0=*reinterpret_cast<const bf16x8*>(kb+d0*2048);
    const bf16x8 b1=*reinterpret_cast<const bf16x8*>(kb+d0*2048+512);
    if(d0==0){p0=__builtin_amdgcn_mfma_f32_32x32x16_bf16(b0,qr[0],negm,0,0,0);p1=__builtin_amdgcn_mfma_f32_32x32x16_bf16(b1,qr[0],negm,0,0,0);}
    else{p0=__builtin_amdgcn_mfma_f32_32x32x16_bf16(b0,qr[d0],p0,0,0,0);p1=__builtin_amdgcn_mfma_f32_32x32x16_bf16(b1,qr[d0],p1,0,0,0);}}
}
typedef __attribute__((address_space(3))) const char* lds_cptr;
typedef short v4i16_t __attribute__((ext_vector_type(4)));
__device__ __forceinline__ void kload8(bf16x8*kf,lds_cptr kp){
  kf[0]=*(const __attribute__((address_space(3))) bf16x8*)(kp);      kf[1]=*(const __attribute__((address_space(3))) bf16x8*)(kp+512);
  kf[2]=*(const __attribute__((address_space(3))) bf16x8*)(kp+2048); kf[3]=*(const __attribute__((address_space(3))) bf16x8*)(kp+2560);
  kf[4]=*(const __attribute__((address_space(3))) bf16x8*)(kp+4096); kf[5]=*(const __attribute__((address_space(3))) bf16x8*)(kp+4608);
  kf[6]=*(const __attribute__((address_space(3))) bf16x8*)(kp+6144); kf[7]=*(const __attribute__((address_space(3))) bf16x8*)(kp+6656);
}
__device__ __forceinline__ void kload2(bf16x8*kf,lds_cptr kp,int j){ kf[2*j]=*(const __attribute__((address_space(3))) bf16x8*)(kp+j*2048); kf[2*j+1]=*(const __attribute__((address_space(3))) bf16x8*)(kp+j*2048+512); }
__device__ __forceinline__ s16x4 vtr(lds_cptr p){ return __builtin_bit_cast(s16x4,__builtin_amdgcn_ds_read_tr16_b64_v4i16((__attribute__((address_space(3))) v4i16_t*)p)); }
__device__ __forceinline__ float rowmax(const f32x16&p0,const f32x16&p1){
  float a=max3f(p0[0],p0[1],p1[0]),b=max3f(p0[2],p0[3],p1[1]);a=max3f(a,p1[2],p1[3]);
  #pragma unroll
  for(int r=4;r<16;r+=4){a=max3f(a,p0[r],p0[r+1]);b=max3f(b,p0[r+2],p0[r+3]);a=max3f(a,p1[r],p1[r+1]);b=max3f(b,p1[r+2],p1[r+3]);}
  const float m=max2f(a,b);
  auto rr=__builtin_amdgcn_permlane32_swap(__float_as_uint(m),__float_as_uint(m),false,false);
  return max2f(__uint_as_float(rr[0]),__uint_as_float(rr[1]));
}
__device__ __forceinline__ void pv(f32x16*o,int vb,bf16x8 pa0,bf16x8 pa1,bf16x8 pa2,bf16x8 pa3){
  #pragma unroll
  for(int d0=0;d0<2;++d0){s16x4 lo[4],hi[4];
    #pragma unroll
    for(int ks=0;ks<4;++ks){
      asm volatile("ds_read_b64_tr_b16 %0,%1 offset:%c2":"=&v"(lo[ks]):"v"(vb),"i"(d0*4096+ks*1024):"memory");
      asm volatile("ds_read_b64_tr_b16 %0,%1 offset:%c2":"=&v"(hi[ks]):"v"(vb),"i"(d0*4096+ks*1024+512):"memory");}
    asm volatile("s_waitcnt lgkmcnt(0)":::"memory");SBAR();
    #define PK(k) (bf16x8){lo[k][0],lo[k][1],lo[k][2],lo[k][3],hi[k][0],hi[k][1],hi[k][2],hi[k][3]}
    o[d0]=__builtin_amdgcn_mfma_f32_32x32x16_bf16(pa0,PK(0),o[d0],0,0,0);
    o[d0]=__builtin_amdgcn_mfma_f32_32x32x16_bf16(pa1,PK(1),o[d0],0,0,0);
    o[d0]=__builtin_amdgcn_mfma_f32_32x32x16_bf16(pa2,PK(2),o[d0],0,0,0);
    o[d0]=__builtin_amdgcn_mfma_f32_32x32x16_bf16(pa3,PK(3),o[d0],0,0,0);
    #undef PK
  }
}

#ifndef ATTN_STORE16
#define ATTN_STORE16(p,v) (*(u32x4*)(p)=(v))
#endif
template<int THRL,bool STATIC> __device__ __forceinline__ void attn_unit(const bf16*Qu,const int QP,const bf16*__restrict__ Kh,const bf16*__restrict__ Vh,const int KP,const int NT,bf16*Ou,const int OP,char*shm,const float mstat){
  int tid_=threadIdx.x; asm volatile("":"+v"(tid_));
  const int tid=tid_,lane=tid&63,r32=lane&31,hi=lane>>5; const int wid=__builtin_amdgcn_readfirstlane(tid>>6);
  const bf16*Qw=Qu+(long)(wid*QBLK)*QP;
  const unsigned lds0=(unsigned)(uintptr_t)shm;
  float*wsf=(float*)(shm+LDS_WS)+wid*64;
  const bf16*ksrc=Kh+wid*512+lane*8;
  const bf16*vsrc=Vh+wid*512+lane*8; (void)KP;
  const unsigned kdst=lds0+LDS_K+wid*1024, vdst=lds0+LDS_V+wid*1024;
  #define DMA_K(t,slot) glds16(ksrc+(long)(t)*4096,(unsigned)__builtin_amdgcn_readfirstlane(kdst+(slot)))
  #define DMA_V(t,slot) glds16(vsrc+(long)(t)*4096,(unsigned)__builtin_amdgcn_readfirstlane(vdst+(slot)))
  const int vb0=(int)(lds0+LDS_V)+((lane>>4)&1)*32+(lane&3)*8+(4*hi+((lane&15)>>2))*64;
  const char*Kbase=shm+LDS_K; bf16x8 kf[8];
  const lds_cptr shm3=(lds_cptr)shm; const lds_cptr kp0=shm3+LDS_K+hi*1024+r32*16; const lds_cptr vp0=shm3+LDS_V+((lane>>4)&1)*32+(lane&3)*8+(4*hi+((lane&15)>>2))*64;
  DMA_K(0,0);DMA_V(0,0);DMA_K(1,SLOTB);
  bf16x8 qr[4];
  #pragma unroll
  for(int d0=0;d0<4;++d0)qr[d0]=*reinterpret_cast<const bf16x8*>(&Qw[(long)r32*QP+d0*16+hi*8]);
  float mhat=0.f,l_reg=0.f;f32x16 o[2];o[0]=f32x16{};o[1]=f32x16{};f32x16 negm=f32x16{};asm volatile("":"+v"(negm));
  #define CMASK(P0,P1,t) do{}while(0)
  bool resc=false;
  #define START(P0,P1) do{ float rm; if constexpr(STATIC){rm=mstat;}else{rm=rowmax(P0,P1);} resc=false; \
    { const float dl=rm; mhat=fadd_s(mhat,dl); \
      _Pragma("unroll") for(int r=0;r<16;++r){P0[r]=fsub_s(P0[r],dl);P1[r]=fsub_s(P1[r],dl);} \
      _Pragma("unroll") for(int r=0;r<16;++r)negm[r]=-mhat; asm volatile("":"+v"(negm)); } \
    _Pragma("unroll") for(int r=0;r<16;++r)P0[r]=__builtin_amdgcn_exp2f(P0[r]); }while(0)
  #define RESC() do{ if(resc){ asm volatile("s_waitcnt lgkmcnt(0)":::"memory"); \
      _Pragma("unroll") for(int d_=0;d_<2;++d_) _Pragma("unroll") for(int r=0;r<16;++r)o[d_][r]*=wsf[crow(r,hi)]; } }while(0)
  f32x16 pA0,pA1,pB0,pB1;
  int sl_prev=0,sl_cur=0,sl_next=SLOTB;
  #define ROT() do{sl_prev=sl_cur;sl_cur=sl_next;sl_next=(sl_next==(NSLOT-1)*SLOTB)?0:sl_next+SLOTB;}while(0)
  DMA_K(2,2*SLOTB);
  WAIT_BAR(3);
  qkt(pA0,pA1,Kbase,qr,negm,r32,hi);asm volatile("s_nop 15\n\ts_nop 7":"+v"(pA0),"+v"(pA1));CMASK(pA0,pA1,0);
  START(pA0,pA1);
  _Pragma("unroll") for(int r=0;r<16;++r)pA1[r]=__builtin_amdgcn_exp2f(pA1[r]);
  WAIT_BAR(0);
  DMA_K(3,0);DMA_V(1,SLOTB);
  ROT();
  kload8(kf,kp0+sl_cur);
  WAIT_BAR(2);
  s16x4 vlo[8],vhi[8]; u32x4 pw0,pw1,pw2,pw3;
  #define PKW(P,B) cvtpk_s(P[B],P[B+1])
  #define PAF(k) __builtin_bit_cast(bf16x8,pw##k)
  #define VFR(i) (bf16x8){vlo[i][0],vlo[i][1],vlo[i][2],vlo[i][3],vhi[i][0],vhi[i][1],vhi[i][2],vhi[i][3]}
  #define PIN(x) asm volatile("":"+v"(x))
  #define MX3(a,b,c) __builtin_fmaxf(__builtin_fmaxf((a),(b)),(c))
  #define GAPA(MF,A0,A1,A2,A3,W0,W1,PW) do{ MF; sacc+=A0; sacc+=A1; sacc+=A2; sacc+=A3; PIN(sacc); W0; W1; PIN(PW); SBAR(); }while(0)
  #define EX(v) __builtin_amdgcn_exp2f(v)
  #define GAPB(MF,X,B) do{ MF; X[B]=EX(X[B]); X[B+1]=EX(X[B+1]); X[B+2]=EX(X[B+2]); X[B+3]=EX(X[B+3]); PIN(X); SBAR(); }while(0)
  #define VRD(i) do{ vlo[i]=vtr(vp_+(((i)>>2)*4096+((i)&3)*1024)); vhi[i]=vtr(vp_+(((i)>>2)*4096+((i)&3)*1024+512)); }while(0)
  #define KRD(G,j) do{ if(G){ kload2(kf,kp0+sl_next,j); SBAR(); } }while(0)
  #define STEP(C0,C1,P0,P1,t,GK,GV,GL) do{ SBAR(); \
    const lds_cptr vp_=vp0+sl_prev; \
    VRD(0); SBAR(); float sacc=(P0[0]+P0[1]); \
    GAPA(C0=__builtin_amdgcn_mfma_f32_32x32x16_bf16(kf[0],qr[0],negm,0,0,0), P0[2],P0[3],P0[4],P0[5],     pw0[0]=PKW(P0,0), pw0[1]=PKW(P0,2), pw0); \
    VRD(4); SBAR(); GAPA(C1=__builtin_amdgcn_mfma_f32_32x32x16_bf16(kf[1],qr[0],negm,0,0,0), P0[6],P0[7],P0[8],P0[9],     pw0[2]=PKW(P0,4), pw0[3]=PKW(P0,6), pw0); \
    VRD(1); SBAR(); GAPA(C0=__builtin_amdgcn_mfma_f32_32x32x16_bf16(kf[2],qr[1],C0,0,0,0),   P0[10],P0[11],P0[12],P0[13], pw1[0]=PKW(P0,8), pw1[1]=PKW(P0,10), pw1); \
    VRD(5); SBAR(); GAPA(C1=__builtin_amdgcn_mfma_f32_32x32x16_bf16(kf[3],qr[1],C1,0,0,0),   P0[14],P0[15],P1[0],P1[1],   pw1[2]=PKW(P0,12),pw1[3]=PKW(P0,14), pw1); \
    VRD(2); SBAR(); GAPA(C0=__builtin_amdgcn_mfma_f32_32x32x16_bf16(kf[4],qr[2],C0,0,0,0),   P1[2],P1[3],P1[4],P1[5],     pw2[0]=PKW(P1,0), pw2[1]=PKW(P1,2), pw2); \
    VRD(6); SBAR(); GAPA(C1=__builtin_amdgcn_mfma_f32_32x32x16_bf16(kf[5],qr[2],C1,0,0,0),   P1[6],P1[7],P1[8],P1[9],     pw2[2]=PKW(P1,4), pw2[3]=PKW(P1,6), pw2); \
    VRD(3); SBAR(); GAPA(C0=__builtin_amdgcn_mfma_f32_32x32x16_bf16(kf[6],qr[3],C0,0,0,0),   P1[10],P1[11],P1[12],P1[13], pw3[0]=PKW(P1,8), pw3[1]=PKW(P1,10), pw3); \
    VRD(7); SBAR(); GAPA(C1=__builtin_amdgcn_mfma_f32_32x32x16_bf16(kf[7],qr[3],C1,0,0,0),   P1[14],P1[15],0.f,0.f,       pw3[2]=PKW(P1,12),pw3[3]=PKW(P1,14), pw3); \
    l_reg+=sacc; \
    if(GK){DMA_K((t)+3,sl_cur);} if(GV){DMA_V((t)+1,sl_next);} \
    CMASK(C0,C1,t); \
    if constexpr(!STATIC){ float a=MX3(C0[0],C0[1],C1[0]),b=MX3(C0[2],C0[3],C1[1]); a=MX3(a,C1[2],C1[3]); \
      _Pragma("unroll") for(int r=4;r<16;r+=4){a=MX3(a,C0[r],C0[r+1]);b=MX3(b,C0[r+2],C0[r+3]);a=MX3(a,C1[r],C1[r+1]);b=MX3(b,C1[r+2],C1[r+3]);} \
      float rm=__builtin_fmaxf(a,b); { auto rr=__builtin_amdgcn_permlane32_swap(__float_as_uint(rm),__float_as_uint(rm),false,false); rm=__builtin_fmaxf(__uint_as_float(rr[0]),__uint_as_float(rr[1])); } \
      resc=false; \
      if(__builtin_expect(__any(rm>(float)THRL),0)){ const float dl=__builtin_fmaxf(rm,0.f); mhat+=dl; \
        _Pragma("unroll") for(int r=0;r<16;++r){C0[r]-=dl;C1[r]-=dl;} \
        _Pragma("unroll") for(int r=0;r<16;++r)negm[r]=-mhat; asm volatile("":"+v"(negm)); \
        const float f=__builtin_amdgcn_exp2f(-dl); l_reg*=f; if(hi==0)wsf[r32]=f; resc=true; } } \
    SBAR(); \
    GAPB(o[0]=__builtin_amdgcn_mfma_f32_32x32x16_bf16(PAF(0),VFR(0),o[0],0,0,0), C0,0); \
    GAPB(o[1]=__builtin_amdgcn_mfma_f32_32x32x16_bf16(PAF(0),VFR(4),o[1],0,0,0), C0,4); \
    KRD(GL,0); GAPB(o[0]=__builtin_amdgcn_mfma_f32_32x32x16_bf16(PAF(1),VFR(1),o[0],0,0,0), C0,8); \
    KRD(GL,1); GAPB(o[1]=__builtin_amdgcn_mfma_f32_32x32x16_bf16(PAF(1),VFR(5),o[1],0,0,0), C0,12); \
    KRD(GL,2); GAPB(o[0]=__builtin_amdgcn_mfma_f32_32x32x16_bf16(PAF(2),VFR(2),o[0],0,0,0), C1,0); \
    KRD(GL,3); GAPB(o[1]=__builtin_amdgcn_mfma_f32_32x32x16_bf16(PAF(2),VFR(6),o[1],0,0,0), C1,4); \
    GAPB(o[0]=__builtin_amdgcn_mfma_f32_32x32x16_bf16(PAF(3),VFR(3),o[0],0,0,0), C1,8); \
    GAPB(o[1]=__builtin_amdgcn_mfma_f32_32x32x16_bf16(PAF(3),VFR(7),o[1],0,0,0), C1,12); \
    }while(0)
  int t=1;
  #undef CMASK
  #define CMASK(P0,P1,t) do{}while(0)
  for(;t+5<NT;t+=2){
    STEP(pB0,pB1,pA0,pA1,t,true,true,true);     WAIT_BAR(2); RESC(); ROT();
    STEP(pA0,pA1,pB0,pB1,t+1,true,true,true);   WAIT_BAR(2); RESC(); ROT();
  }
  #undef CMASK
  #define CMASK(P0,P1,t) do{}while(0)
  #define ENDW(tt) do{ if((tt)+3<NT){WAIT_BAR(2);} else if((tt)+2<NT){WAIT_BAR(1);} else {WAIT_BAR(0);} }while(0)
  for(;t+1<NT;t+=2){
    STEP(pB0,pB1,pA0,pA1,t,(t+3<NT),(t+1<NT),(t+1<NT));       ENDW(t);   RESC(); ROT();
    STEP(pA0,pA1,pB0,pB1,t+1,(t+4<NT),(t+2<NT),(t+2<NT));     ENDW(t+1); RESC(); ROT();
  }
  STEP(pB0,pB1,pA0,pA1,NT-1,false,false,false); RESC();
  { float sacc=pB0[0]+pB0[1]; _Pragma("unroll") for(int r=2;r<16;++r)sacc+=pB0[r]; _Pragma("unroll") for(int r=0;r<16;++r)sacc+=pB1[r]; l_reg+=sacc;
    pw0=(u32x4){PKW(pB0,0),PKW(pB0,2),PKW(pB0,4),PKW(pB0,6)};pw1=(u32x4){PKW(pB0,8),PKW(pB0,10),PKW(pB0,12),PKW(pB0,14)};pw2=(u32x4){PKW(pB1,0),PKW(pB1,2),PKW(pB1,4),PKW(pB1,6)};pw3=(u32x4){PKW(pB1,8),PKW(pB1,10),PKW(pB1,12),PKW(pB1,14)};
    SBAR(); pv(o,vb0+sl_cur,PAF(0),PAF(1),PAF(2),PAF(3)); }
  #undef PKW
  #undef PAF
  #undef VFR
  #undef PIN
  #undef MX3
  #undef GAPA
  #undef GAPB
  #undef EX
  #undef VRD
  #undef KRD
  #undef STEP
  #undef ENDW
  {auto rr=__builtin_amdgcn_permlane32_swap(__float_as_uint(l_reg),__float_as_uint(l_reg),false,false);l_reg=__uint_as_float(rr[0])+__uint_as_float(rr[1]);}
  if(hi==0)wsf[32+r32]=l_reg;asm volatile("s_waitcnt lgkmcnt(0)":::"memory");
  float rli[16];
  #pragma unroll
  for(int r=0;r<16;++r)rli[r]=__builtin_amdgcn_rcpf(wsf[32+crow(r,hi)]);
  bf16*Ow=Ou+(long)(wid*QBLK)*OP;
  { bf16*stg=(bf16*)(shm+LDS_OST)+wid*2048;
    #pragma unroll
    for(int r=0;r<16;++r){const int orow=crow(r,hi);
      #pragma unroll
      for(int d0=0;d0<2;++d0)stg[orow*64+d0*32+r32]=__float2bfloat16(o[d0][r]*rli[r]);}
    asm volatile("s_waitcnt lgkmcnt(0)":::"memory");
    #pragma unroll
    for(int i=0;i<4;++i){const int row=i*8+(lane>>3),ch=lane&7; const u32x4 v=*(const u32x4*)(stg+row*64+ch*8); ATTN_STORE16(Ow+(long)row*OP+ch*8,v);} }
  asm volatile("s_waitcnt lgkmcnt(0)\n\ts_barrier":::"memory");
  #undef DMA_K
  #undef DMA_V
  #undef CMASK
  #undef START
  #undef RESC
  #undef ROT
}
constexpr int ATTN_LDS_BYTES=LDS_BYTES;
#undef SBAR
#undef WAIT_BAR
}
#ifndef REP_P0
#define REP_P0 1
#endif
#ifndef REP_PA
#define REP_PA 1
#endif
#ifndef REP_PB
#define REP_PB 1
#endif
#ifndef REP_PC
#define REP_PC 1
#endif
#ifndef REP_PE
#define REP_PE 1
#endif
#ifndef REP_PF
#define REP_PF 1
#endif
#ifndef REP_PG
#define REP_PG 1
#endif

#include <hip/hip_cooperative_groups.h>
namespace cg = cooperative_groups;
#define LAS __attribute__((address_space(3)))
#define GAS_ __attribute__((address_space(1)))
typedef unsigned short bf16;
typedef unsigned v4u __attribute__((ext_vector_type(4)));
typedef unsigned v2u __attribute__((ext_vector_type(2)));
typedef float f32x4 __attribute__((ext_vector_type(4)));
typedef float f32x2 __attribute__((ext_vector_type(2)));
typedef short bf16x8 __attribute__((ext_vector_type(8)));

constexpr int NWAVES = 8, NTHR = 512;
constexpr int DMOD = 1024, NLAT = 16384, NCTXR = 512, MROWS = 16896, SEQL = 8192, CTXL = 256, NLAYER = 4;
constexpr int DIN = 2048, DFF = 2816, DUP = 5632, KVROWS = 8448, NMOD = 6;
constexpr float EPS = 1e-6f;
constexpr float QSCALE = 0.125f * 1.4426950408889634f;

constexpr size_t MiB = 1u << 20;
constexpr size_t WS_MODV = 0;
constexpr size_t WS_BAR = 384 * 1024;
constexpr size_t WS_PTRS = 448 * 1024;
constexpr size_t WS_ROPE = 512 * 1024;
constexpr size_t WS_XSC = 1 * MiB;
constexpr size_t WS_W0 = 4 * MiB, WS_W1 = 258 * MiB, WS_WSTRIDE = 23592960;
constexpr size_t WO_WIN = 0, WO_WOUT = 4 * MiB, WO_WUP = 6 * MiB, WO_WDN = 17 * MiB;
constexpr size_t WS_CNT = 400 * 1024;
constexpr size_t WS_ACT = 28 * MiB;
constexpr size_t WS_Q = 120 * MiB;
constexpr size_t WS_K = WS_Q + (size_t)MROWS * 512 * 2;
constexpr size_t WS_V = WS_K + (size_t)MROWS * 128 * 2;
constexpr size_t WS_U = WS_V + (size_t)MROWS * 128 * 2;
constexpr size_t WS_VN = WS_U + (size_t)MROWS * 256 * 2;
constexpr size_t WS_CB = WS_VN + (size_t)MROWS * 256 * 2;
constexpr size_t WS_CCH = WS_CB + (size_t)MROWS * 256 * 2;
constexpr size_t WS_MIX = WS_CCH + (size_t)MROWS * 256 * 2;
constexpr size_t WS_HALO = 211 * MiB;
constexpr size_t WS_H = 224 * MiB;
constexpr size_t WS_XB = WS_W1 + WS_WSTRIDE;
constexpr size_t WS_END = WS_XB + (size_t)NLAT * 1024 * 2;
static_assert(WS_MIX + (size_t)MROWS * 1024 * 2 <= WS_HALO && WS_HALO + (size_t)(MROWS / 128) * 4 * DUP * 4 <= WS_H && WS_ACT + (size_t)MROWS * DFF * 2 <= WS_Q && WS_W0 + WS_WSTRIDE <= WS_ACT && WO_WDN + (size_t)1024 * DFF * 2 <= WS_WSTRIDE && WS_H + (size_t)MROWS * 1024 * 2 <= WS_W1, "ws map");

constexpr int RING_BYTES = 131072, LDS_BYTES = 147456;

__device__ __forceinline__ unsigned pk2(float lo, float hi) { return pg8::cvt_pk_bf16(lo, hi); }
__device__ __forceinline__ float bf_lo(unsigned w) { return __uint_as_float(w << 16); }
__device__ __forceinline__ float bf_hi(unsigned w) { return __uint_as_float(w & 0xffff0000u); }
__device__ __forceinline__ float sigmoid_f(float x) { return __builtin_amdgcn_rcpf(1.f + __builtin_amdgcn_exp2f(-1.4426950408889634f * x)); }
__device__ __forceinline__ float silu_f(float x) { return x * sigmoid_f(x); }
__device__ __forceinline__ float gelu_t(float x) { const float z = 0.7978845608028654f * (x + 0.044715f * x * x * x); return x * sigmoid_f(2.f * z); }
__device__ __forceinline__ float wave_sum(float v) {
#pragma unroll
    for (int o = 1; o < 64; o <<= 1) v += __shfl_xor(v, o);
    return v;
}

namespace pg8 {
typedef unsigned u32x2 __attribute__((ext_vector_type(2)));
struct EpiResid {
    static constexpr bool PERM = true, AFTER_DRAIN = false, ROWPERM = false;
    const bf16_t* base_lat; bf16_t* out_lat; const float* modv; int gi;
    __device__ __forceinline__ void operator()(const f32x4 (&acc)[2][2][4][2], const Unit& u, int wr, int wc, int fr, int fq) const {
        const int s = u.pm < 32 ? 0 : 1;
        const float* g = modv + (size_t)(s * 6 + gi) * 1024;
        const bf16_t* bp = base_lat + (size_t)u.pm * 256 * 1024; bf16_t* op = out_lat + (size_t)u.pm * 256 * 1024;
        const int col0 = u.pn * 256 + wc * 32 + 8 * fq;
        f32x4 gv[2][2];
#pragma unroll
        for (int bj = 0; bj < 2; ++bj)
#pragma unroll
            for (int n = 0; n < 2; ++n) gv[bj][n] = *(const f32x4*)(g + col0 + bj * 128 + 4 * n);
#pragma unroll
        for (int ai = 0; ai < 2; ++ai) {
        u32x4 b[4][2];
#pragma unroll
            for (int m = 0; m < 4; ++m) { const size_t off = (size_t)(ai * 128 + wr * 64 + m * 16 + fr) * 1024 + col0;
#pragma unroll
                for (int bj = 0; bj < 2; ++bj) b[m][bj] = *(const u32x4*)(bp + off + bj * 128); }
        asm volatile("" ::: "memory");
#pragma unroll
            for (int m = 0; m < 4; ++m) { const size_t off = (size_t)(ai * 128 + wr * 64 + m * 16 + fr) * 1024 + col0;
#pragma unroll
                for (int bj = 0; bj < 2; ++bj) { const u32x4 w = b[m][bj];
                    const f32x4 x0 = (f32x4){__uint_as_float(w.x << 16), __uint_as_float(w.x & 0xffff0000u), __uint_as_float(w.y << 16), __uint_as_float(w.y & 0xffff0000u)} + gv[bj][0] * acc[ai][bj][m][0];
                    const f32x4 x1 = (f32x4){__uint_as_float(w.z << 16), __uint_as_float(w.z & 0xffff0000u), __uint_as_float(w.w << 16), __uint_as_float(w.w & 0xffff0000u)} + gv[bj][1] * acc[ai][bj][m][1];
                    u32x4 o; o.x = cvt_pk_bf16(x0[0], x0[1]); o.y = cvt_pk_bf16(x0[2], x0[3]); o.z = cvt_pk_bf16(x1[0], x1[1]); o.w = cvt_pk_bf16(x1[2], x1[3]);
                    *(u32x4*)(op + off + bj * 128) = o; } }
        asm volatile("" ::: "memory");
        }
    }
};

struct EpiProj {
    static constexpr bool PERM = true, AFTER_DRAIN = false, ROWPERM = false;
    bf16_t *Q, *KB, *VB, *U, *VN, *CB, *CCH;
    const float *qg, *kg; const f32x2* rope;
    __device__ __forceinline__ static void st8(bf16_t* p, const float (&o)[8]) {
        u32x4 w; w.x = cvt_pk_bf16(o[0], o[1]); w.y = cvt_pk_bf16(o[2], o[3]); w.z = cvt_pk_bf16(o[4], o[5]); w.w = cvt_pk_bf16(o[6], o[7]); *(u32x4*)p = w;
    }
    __device__ __forceinline__ void operator()(const f32x4 (&acc)[2][2][4][2], const Unit& u, int wr, int wc, int fr, int fq) const {
        const int pn = u.pn, pm = u.pm;
        const bool isctx = pm >= 64;
        const int kvb = isctx ? (pm - 64) : (pm >> 5), kvr0 = isctx ? 0 : 256 + (pm & 31) * 256;
        const int dof = 8 * fq;
        float gq[2][8];
        const bool qk = (pn == 2 || pn == 3 || (pn == 4 && wc < 2));
        if (qk) { const float* gp = (pn == 4) ? kg : qg;
#pragma unroll
            for (int bj = 0; bj < 2; ++bj)
#pragma unroll
                for (int k = 0; k < 8; ++k) gq[bj][k] = gp[32 * bj + dof + k]; }
#pragma unroll
        for (int ai = 0; ai < 2; ++ai)
#pragma unroll
            for (int m = 0; m < 4; ++m) {
                const int rl = ai * 128 + wr * 64 + m * 16 + fr; const int gm = pm * 256 + rl;
                float v[2][8];
#pragma unroll
                for (int bj = 0; bj < 2; ++bj)
#pragma unroll
                    for (int n = 0; n < 2; ++n)
#pragma unroll
                        for (int i = 0; i < 4; ++i) v[bj][4 * n + i] = acc[ai][bj][m][n][i];
                if (pn == 0) {
#pragma unroll
                    for (int bj = 0; bj < 2; ++bj) { float o[8];
#pragma unroll
                        for (int k = 0; k < 8; ++k) o[k] = gelu_t(v[bj][k]);
                        st8(U + (size_t)gm * 256 + 64 * wc + 32 * bj + dof, o); }
                } else if (pn == 1) {
                    float s = 0.f;
#pragma unroll
                    for (int bj = 0; bj < 2; ++bj)
#pragma unroll
                        for (int k = 0; k < 8; ++k) { v[bj][k] = gelu_t(v[bj][k]); s += v[bj][k]; }
                    s += __shfl_xor(s, 16); s += __shfl_xor(s, 32);
                    const float mean = s * (1.f / 64.f); float q = 0.f;
#pragma unroll
                    for (int bj = 0; bj < 2; ++bj)
#pragma unroll
                        for (int k = 0; k < 8; ++k) { v[bj][k] -= mean; q += v[bj][k] * v[bj][k]; }
                    q += __shfl_xor(q, 16); q += __shfl_xor(q, 32);
                    const float rstd = rsqrtf(q * (1.f / 64.f) + EPS);
#pragma unroll
                    for (int bj = 0; bj < 2; ++bj) { float o[8];
#pragma unroll
                        for (int k = 0; k < 8; ++k) o[k] = v[bj][k] * rstd;
                        st8(VN + (size_t)gm * 256 + 64 * wc + 32 * bj + dof, o); }
                } else if (qk) {
                    float ss = 0.f;
#pragma unroll
                    for (int bj = 0; bj < 2; ++bj)
#pragma unroll
                        for (int k = 0; k < 8; ++k) ss += v[bj][k] * v[bj][k];
                    ss += __shfl_xor(ss, 16); ss += __shfl_xor(ss, 32);
                    const float r = rsqrtf(ss * (1.f / 64.f) + EPS);
                    const int t = gm & (SEQL - 1);
                    const float osc = (pn == 4) ? 1.f : QSCALE;
#pragma unroll
                    for (int bj = 0; bj < 2; ++bj) { float o[8];
                        const int pos = (bj == 0) ? (t >> 6) : (t & 63);
                        const f32x2* rp = rope + pos * 16 + 8 * (fq & 1);
#pragma unroll
                        for (int k = 0; k < 8; ++k) {
                            float y = v[bj][k] * r * gq[bj][k];
                            if (!isctx) { const float pr = __shfl_xor(y, 32); const f32x2 cs = rp[k]; y = (fq < 2) ? (y * cs.x - pr * cs.y) : (y * cs.x + pr * cs.y); }
                            o[k] = y * osc; }
                        if (pn == 4) { const int kvr = kvr0 + rl; st8(KB + ((((size_t)(kvb * 2 + wc) * (KVROWS / 64) + (kvr >> 6)) * 8 + (4 * bj + fq)) * 64 + (kvr & 63)) * 8, o); }
                        else st8(Q + (size_t)gm * 512 + 64 * (4 * (pn - 2) + wc) + 32 * bj + dof, o); }
                } else if (pn == 4) {
#pragma unroll
                    for (int bj = 0; bj < 2; ++bj) { const int kvr = kvr0 + rl; st8(VB + ((((size_t)(kvb * 2 + wc - 2) * (KVROWS / 64) + (kvr >> 6)) * 8 + (4 * bj + ((kvr >> 4) & 3))) * 16 + (kvr & 15)) * 32 + dof, v[bj]); }
                } else if (pn == 5) {
#pragma unroll
                    for (int bj = 0; bj < 2; ++bj) st8(CB + (size_t)gm * 256 + 64 * wc + 32 * bj + dof, v[bj]);
                } else {
                    float o[8];
#pragma unroll
                    for (int k = 0; k < 8; ++k) o[k] = v[0][k] * v[1][k];
                    st8(CCH + (size_t)gm * 256 + 128 * (pn - 6) + 32 * wc + dof, o);
                }
            }
    }
};
struct EpiUpConv {
    static constexpr bool PERM = true, AFTER_DRAIN = false, ROWPERM = true;
    bf16_t* ACT; float* HALO; const float* cw;
    __device__ __forceinline__ void operator()(const f32x4 (&acc)[2][2][4][2], const Unit& u, int wr, int wc, int fr, int fq) const {
        const int rbase = u.pm * 256 + 128 * wr + 8 * fr, seg = u.pm * 2 + wr;
        const int ch0 = 128 * u.pn + 32 * wc + 8 * fq;
        unsigned pk[8][4];
#pragma unroll
        for (int n = 0; n < 2; ++n) {
            const int ch = ch0 + 4 * n;
            const f32x4 wa0 = *(const f32x4*)(cw + ch), wa1 = *(const f32x4*)(cw + DUP + ch), wa2 = *(const f32x4*)(cw + 2 * DUP + ch);
            const f32x4 wg0 = *(const f32x4*)(cw + DFF + ch), wg1 = *(const f32x4*)(cw + DUP + DFF + ch), wg2 = *(const f32x4*)(cw + 2 * DUP + DFF + ch);
            float act[8][4];
#pragma unroll
            for (int i = 0; i < 4; ++i) {
                float a[10], g[10];
#pragma unroll
                for (int ai = 0; ai < 2; ++ai)
#pragma unroll
                    for (int m = 0; m < 4; ++m) { a[1 + 4 * ai + m] = acc[ai][0][m][n][i]; g[1 + 4 * ai + m] = acc[ai][1][m][n][i]; }
                const float au = __shfl_up(a[8], 1, 16), ad = __shfl_down(a[1], 1, 16), gu = __shfl_up(g[8], 1, 16), gd = __shfl_down(g[1], 1, 16);
                a[0] = fr == 0 ? 0.f : au; a[9] = fr == 15 ? 0.f : ad; g[0] = fr == 0 ? 0.f : gu; g[9] = fr == 15 ? 0.f : gd;
#pragma unroll
                for (int j = 0; j < 8; ++j) {
                    const float ca = wa0[i] * a[j] + wa1[i] * a[j + 1] + wa2[i] * a[j + 2];
                    const float cg = wg0[i] * g[j] + wg1[i] * g[j + 1] + wg2[i] * g[j + 2];
                    act[j][i] = silu_f(cg) * ca;
                }
            }
#pragma unroll
            for (int j = 0; j < 8; ++j) { pk[j][2 * n] = cvt_pk_bf16(act[j][0], act[j][1]); pk[j][2 * n + 1] = cvt_pk_bf16(act[j][2], act[j][3]); }
        }
#pragma unroll
        for (int j = 0; j < 8; ++j) { u32x4 w; w.x = pk[j][0]; w.y = pk[j][1]; w.z = pk[j][2]; w.w = pk[j][3]; *(u32x4*)(ACT + (size_t)(rbase + j) * DFF + ch0) = w; }
        if (fr == 0 || fr == 15) {
            float* hp = HALO + (size_t)(seg * 4 + (fr == 0 ? 0 : 2)) * DUP + ch0;
#pragma unroll
            for (int bj = 0; bj < 2; ++bj)
#pragma unroll
                for (int n = 0; n < 2; ++n) {
                    const f32x4 r0 = fr == 0 ? acc[0][bj][0][n] : acc[1][bj][2][n], r1 = fr == 0 ? acc[0][bj][1][n] : acc[1][bj][3][n];
                    *(f32x4*)(hp + bj * DFF + 4 * n) = r0; *(f32x4*)(hp + DUP + bj * DFF + 4 * n) = r1;
                }
        }
    }
};
}

__device__ __forceinline__ int win_map(int L) {
    if (L < 1536) { const int T = L >> 8, l = L & 255, head = l >> 6, d = l & 63; return 256 * T + 128 * (d >> 5) + 32 * head; }
    if (L < 1792) { const int ch = L - 1536; return 256 * (6 + (ch >> 7)) + (ch & 127); }
    const int ch = L - 1792; return 256 * (6 + (ch >> 7)) + 128 + (ch & 127);
}
__device__ __forceinline__ int up_map(int L) { if (L < DFF) return 256 * (L >> 7) + (L & 127); const int ch = L - DFF; return 256 * (ch >> 7) + 128 + (ch & 127); }
template <int MAP> __device__ __forceinline__ void transpose_item(const float* W, int K, int N, bf16* WT, LAS float* scr, int item, int lane) {
    const int nblk = N / 32, kb = item / nblk, nb = item % nblk, k0 = 64 * kb, n0 = 32 * nb;
    const int r0 = MAP == 1 ? win_map(n0) : (MAP == 2 ? up_map(n0) : n0);
    float tmp[32];
#pragma unroll
    for (int i = 0; i < 32; ++i) tmp[i] = W[(size_t)(k0 + 2 * i + (lane >> 5)) * N + n0 + (lane & 31)];
#pragma unroll
    for (int i = 0; i < 32; ++i) scr[(2 * i + (lane >> 5)) * 33 + (lane & 31)] = tmp[i];
    asm volatile("s_waitcnt lgkmcnt(0)" ::: "memory");
    const int c = lane & 7;
#pragma unroll
    for (int j = 0; j < 4; ++j) { const int n = (lane >> 3) + 8 * j; const LAS float* s = scr + (8 * c) * 33 + n;
        v4u o; o.x = pk2(s[0 * 33], s[1 * 33]); o.y = pk2(s[2 * 33], s[3 * 33]); o.z = pk2(s[4 * 33], s[5 * 33]); o.w = pk2(s[6 * 33], s[7 * 33]);
        *(v4u*)(WT + pg8::wt_off(r0 + n, k0 + 8 * c, K / 64, MAP != 0)) = o; }
    asm volatile("s_waitcnt lgkmcnt(0)" ::: "memory");
}
constexpr int CI_IN = 16 * (DIN / 32), CI_OUT = 16 * 32, CI_UP = 16 * (DUP / 32), CI_DN = (DFF / 64) * 32, CONV_ITEMS = CI_IN + CI_OUT + CI_UP + CI_DN;
__device__ __forceinline__ void convert_item(int it, int l, const float* w_in, const float* w_out, const float* ffn_up, const float* ffn_down, unsigned char* ws, LAS float* scr, int lane) {
    unsigned char* wl_ = ws + ((l & 1) ? WS_W1 : WS_W0); int r = it;
    if (r < CI_IN) { transpose_item<1>(w_in + (size_t)l * 1024 * DIN, 1024, DIN, (bf16*)(wl_ + WO_WIN), scr, r, lane); return; } r -= CI_IN;
    if (r < CI_OUT) { transpose_item<3>(w_out + (size_t)l * 1024 * 1024, 1024, 1024, (bf16*)(wl_ + WO_WOUT), scr, r, lane); return; } r -= CI_OUT;
    if (r < CI_UP) { transpose_item<2>(ffn_up + (size_t)l * 1024 * DUP, 1024, DUP, (bf16*)(wl_ + WO_WUP), scr, r, lane); return; } r -= CI_UP;
    transpose_item<3>(ffn_down + (size_t)l * DFF * 1024, DFF, 1024, (bf16*)(wl_ + WO_WDN), scr, r, lane);
}
__device__ __forceinline__ void norm_load(const float* xrow, int lane, f32x4 (&v)[4]) {
    const f32x4* xr = (const f32x4*)xrow + lane;
#pragma unroll
    for (int j = 0; j < 4; ++j) v[j] = xr[64 * j];
}
__device__ __forceinline__ void norm_load_bf(const bf16* xrow, int lane, f32x4 (&v)[4]) {
    const v2u* xr = (const v2u*)xrow + lane;
#pragma unroll
    for (int j = 0; j < 4; ++j) { const v2u w = xr[64 * j]; v[j] = (f32x4){bf_lo(w.x), bf_hi(w.x), bf_lo(w.y), bf_hi(w.y)}; }
}
__device__ __forceinline__ void norm_finish(const f32x4 (&v)[4], const float* g, const float* sh, const float* sc, bf16* orow, int lane) {
    float s = 0.f;
#pragma unroll
    for (int j = 0; j < 4; ++j) s += (v[j].x * v[j].x + v[j].y * v[j].y) + (v[j].z * v[j].z + v[j].w * v[j].w);
    const float r = rsqrtf(wave_sum(s) * (1.f / 1024.f) + EPS);
    v2u* o8 = (v2u*)orow + lane;
#pragma unroll
    for (int j = 0; j < 4; ++j) {
        const f32x4 gg = ((const f32x4*)g)[lane + 64 * j], ss = ((const f32x4*)sh)[lane + 64 * j], cc = ((const f32x4*)sc)[lane + 64 * j];
        const f32x4 y = (v[j] * r * gg) * (cc + 1.f) + ss;
        v2u w; w.x = pk2(y.x, y.y); w.y = pk2(y.z, y.w); o8[64 * j] = w; }
}
#define NORM_ROWS(XLAT, XCTX, GAIN, MODP, SHI, SCI) do { \
    for (int m = gw; m < MROWS; m += 2 * NGW) { const int m2 = m + NGW; const bool has2 = m2 < MROWS; const int mb = has2 ? m2 : m; \
        f32x4 va[4], vb[4]; \
        if (m < NLAT) norm_load_bf((XLAT) + (size_t)m * 1024, lane, va); else norm_load((XCTX) + (size_t)(m - NLAT) * 1024, lane, va); \
        if (mb < NLAT) norm_load_bf((XLAT) + (size_t)mb * 1024, lane, vb); else norm_load((XCTX) + (size_t)(mb - NLAT) * 1024, lane, vb); \
        { const int s_ = m < SEQL ? 0 : (m < NLAT ? 1 : 2); norm_finish(va, (GAIN), (MODP) + (size_t)(s_ * 6 + (SHI)) * 1024, (MODP) + (size_t)(s_ * 6 + (SCI)) * 1024, H + (size_t)m * 1024, lane); } \
        if (has2) { const int s_ = mb < SEQL ? 0 : (mb < NLAT ? 1 : 2); norm_finish(vb, (GAIN), (MODP) + (size_t)(s_ * 6 + (SHI)) * 1024, (MODP) + (size_t)(s_ * 6 + (SCI)) * 1024, H + (size_t)mb * 1024, lane); } \
    } } while (0)

#define XB_TMO      128
#define XB_XCNT(j)  (256  + 64 * (j))
#define XB_XSUB(j)  (1280 + 64 * (j))
#define XB_XGEN(j)  (2304 + 64 * (j))
#define XB_TOP      3328
#define XB_TOPGEN   3392
#define XCD_BAR_WORDS 3456
#define XB_SPIN_CAP (1u << 18)

__device__ __forceinline__ unsigned xb_ld(unsigned* p)              { return __hip_atomic_load(p, __ATOMIC_RELAXED, __HIP_MEMORY_SCOPE_AGENT); }
__device__ __forceinline__ unsigned xb_add(unsigned* p, unsigned v) { return __hip_atomic_fetch_add(p, v, __ATOMIC_RELAXED, __HIP_MEMORY_SCOPE_AGENT); }
__device__ __forceinline__ unsigned xb_xcc_id() { return (unsigned)__builtin_amdgcn_s_getreg((3 << 11) | 20) & 0xFu; }
#define XB_SPIN(cond, bar) do { unsigned _sp = 0; while (cond) { __builtin_amdgcn_s_sleep(1); \
    if ((++_sp & 255u) == 0u) { if (xb_ld(&(bar)[XB_TMO])) break; if (_sp > XB_SPIN_CAP) { atomicAdd(&(bar)[XB_TMO], 1u); break; } } } } while (0)

struct XcdBarrier {
    unsigned* bar; unsigned x;
    volatile LAS unsigned* st;
};

__device__ __forceinline__ XcdBarrier xcd_barrier_post(unsigned* bar, volatile LAS unsigned* st) {
    XcdBarrier b; b.bar = bar; b.x = xb_xcc_id(); b.st = st;
    if (threadIdx.x == 0) (void)xb_add(&bar[XB_XCNT(b.x)], 1u);
    return b;
}
__device__ __forceinline__ void xcd_barrier_complete(unsigned* bar, unsigned x, unsigned& nloc, unsigned& nx) {
    const unsigned G = gridDim.x * gridDim.y * gridDim.z;
    unsigned sum, cnt, mine, sp = 0u;
    for (;;) {
        sum = 0u; cnt = 0u; mine = 0u;
#pragma unroll
        for (unsigned j = 0; j < 16; ++j) { const unsigned c = xb_ld(&bar[XB_XCNT(j)]); sum += c; cnt += (c > 0u) ? 1u : 0u; mine = (j == x) ? c : mine; }
        if (sum == G) break;
        __builtin_amdgcn_s_sleep(1);
        if ((++sp & 255u) == 0u) { if (xb_ld(&bar[XB_TMO])) break; if (sp > XB_SPIN_CAP) { atomicAdd(&bar[XB_TMO], 1u); break; } }
    }
    nloc = mine > 0u ? mine : 1u; nx = cnt > 0u ? cnt : 1u;
}

__device__ __forceinline__ void xcd_barrier(const XcdBarrier& b_) {
    XcdBarrier b = b_; asm volatile("" : "+s"(b.bar), "+s"(b.x));
    asm volatile("s_waitcnt vmcnt(0)" ::: "memory");
    __syncthreads();
    if (threadIdx.x == 0) {
        unsigned* bar = b.bar;
        __builtin_amdgcn_s_waitcnt(0);
        unsigned nloc = b.st[0], nx = b.st[1];
        if (nloc == 0u) { xcd_barrier_complete(bar, b.x, nloc, nx); b.st[0] = nloc; b.st[1] = nx; }
        const unsigned old = xb_add(&bar[XB_XSUB(b.x)], 1u);
        const unsigned gen = old / nloc;
        if (old + 1u == (gen + 1u) * nloc) {
            __builtin_amdgcn_fence(__ATOMIC_RELEASE, "agent");
            asm volatile("s_waitcnt vmcnt(0)" ::: "memory");
            const unsigned og = xb_add(&bar[XB_TOP], 1u);
            const unsigned tg = og / nx;
            if (og + 1u == (tg + 1u) * nx) xb_add(&bar[XB_TOPGEN], 1u);
            else XB_SPIN(xb_ld(&bar[XB_TOPGEN]) == tg, bar);
            __builtin_amdgcn_fence(__ATOMIC_ACQUIRE, "agent");
            xb_add(&bar[XB_XGEN(b.x)], 1u);
            asm volatile("s_waitcnt vmcnt(0)" ::: "memory");
        } else {
            XB_SPIN(xb_ld(&bar[XB_XGEN(b.x)]) == gen, bar);
            __builtin_amdgcn_fence(__ATOMIC_ACQUIRE, "agent");
            asm volatile("s_waitcnt vmcnt(0)" ::: "memory");
        }
    }
    __syncthreads();
}


template <int RT, int NKS, class BOff> __device__ __forceinline__ void small_gemm(const bf16* A, int lda, const bf16* Bw, BOff boff, LAS float* red, int lane, int wave) {
    const int li = lane & 15, kq = lane >> 4, kbase = wave * (NKS * 32) + 8 * kq;
    f32x4 acc[RT][4];
#pragma unroll
    for (int rt = 0; rt < RT; ++rt)
#pragma unroll
        for (int ct = 0; ct < 4; ++ct) acc[rt][ct] = (f32x4){0.f, 0.f, 0.f, 0.f};
    const bf16* ap[RT];
#pragma unroll
    for (int rt = 0; rt < RT; ++rt) ap[rt] = A + (size_t)(16 * rt + li) * lda + kbase;
#pragma unroll
    for (int ks = 0; ks < NKS; ++ks) {
        bf16x8 a[RT], b[4];
#pragma unroll
        for (int rt = 0; rt < RT; ++rt) a[rt] = *(const bf16x8*)(ap[rt] + 32 * ks);
#pragma unroll
        for (int ct = 0; ct < 4; ++ct) b[ct] = *(const bf16x8*)(Bw + boff(16 * ct + li, kbase + 32 * ks));
#pragma unroll
        for (int rt = 0; rt < RT; ++rt)
#pragma unroll
            for (int ct = 0; ct < 4; ++ct) acc[rt][ct] = __builtin_amdgcn_mfma_f32_16x16x32_bf16(b[ct], a[rt], acc[rt][ct], 0, 0, 0);
    }
#pragma unroll
    for (int rt = 0; rt < RT; ++rt)
#pragma unroll
        for (int ct = 0; ct < 4; ++ct) *(LAS f32x4*)(red + ((size_t)wave * (16 * RT) + 16 * rt + li) * 64 + 16 * ct + 4 * kq) = acc[rt][ct];
}
__device__ __forceinline__ void st8g(bf16* p, const float (&o)[8]) { v4u w; w.x = pk2(o[0], o[1]); w.y = pk2(o[2], o[3]); w.z = pk2(o[4], o[5]); w.w = pk2(o[6], o[7]); *(v4u*)p = w; }

__device__ __forceinline__ void final_finish(const f32x4 (&v)[4], const float* g, float* orow, int lane) {
    float s = 0.f;
#pragma unroll
    for (int j = 0; j < 4; ++j) s += (v[j].x * v[j].x + v[j].y * v[j].y) + (v[j].z * v[j].z + v[j].w * v[j].w);
    const float r = rsqrtf(wave_sum(s) * (1.f / 1024.f) + EPS);
#pragma unroll
    for (int j = 0; j < 4; ++j) ((f32x4*)orow)[lane + 64 * j] = v[j] * r * ((const f32x4*)g)[lane + 64 * j];
}
__device__ __forceinline__ void panel_norm(unsigned* cnt, int pm, int pn, int vcu, const bf16* xlat, float* outf, const float* xctx, const float* gain, const float* modp, int shi, int sci, bf16* H, bool fin, bool doctx, int tid, int lane, int wave) {
    asm volatile("s_waitcnt vmcnt(0)" ::: "memory");
    __syncthreads();
    const int rt = vcu >> 4;
    if (tid == 0) {
        __builtin_amdgcn_fence(__ATOMIC_RELEASE, "agent"); asm volatile("s_waitcnt vmcnt(0)" ::: "memory");
        (void)xb_add(cnt + pm, 1u); (void)xb_add(cnt + 64 + rt, 1u);
        unsigned sp = 0; while (xb_ld(cnt + pm) < 4u || (doctx && xb_ld(cnt + 64 + rt) < 16u)) { __builtin_amdgcn_s_sleep(1); if (++sp > (1u << 22)) break; }
        __builtin_amdgcn_fence(__ATOMIC_ACQUIRE, "agent"); asm volatile("s_waitcnt vmcnt(0)" ::: "memory");
    }
    __syncthreads();
    const int s = pm < 32 ? 0 : 1;
    {
        const int r0 = 256 * pm + 64 * pn + 8 * wave;
        f32x4 v8[8][4], vc[4];
#pragma unroll
        for (int i = 0; i < 8; ++i) norm_load_bf(xlat + (size_t)(r0 + i) * 1024, lane, v8[i]);
        const int cr = 32 * rt + 2 * (vcu & 15) + (wave & 1);
        if (doctx && wave < 2) norm_load(xctx + (size_t)cr * 1024, lane, vc);
        asm volatile("" ::: "memory");
#pragma unroll
        for (int i = 0; i < 8; ++i) {
            if (fin) final_finish(v8[i], gain, outf + (size_t)(r0 + i) * 1024, lane);
            else norm_finish(v8[i], gain, modp + (size_t)(s * 6 + shi) * 1024, modp + (size_t)(s * 6 + sci) * 1024, H + (size_t)(r0 + i) * 1024, lane);
        }
        if (doctx && wave < 2) norm_finish(vc, gain, modp + (size_t)(2 * 6 + shi) * 1024, modp + (size_t)(2 * 6 + sci) * 1024, H + (size_t)(NLAT + cr) * 1024, lane);
    }
}

struct Args { const float* in[19]; float* out; unsigned char* ws; unsigned long long zero; };

__global__ void __launch_bounds__(NTHR, 2) fwd_megakernel(Args args) {
    extern __shared__ __attribute__((aligned(16))) unsigned char lds_raw[];
    cg::grid_group grid = cg::this_grid();
    LAS unsigned char* lds = (LAS unsigned char*)lds_raw;
    const int G = gridDim.x; const int bx = blockIdx.x;
    const int vcu = (G % 8 == 0) ? (bx % 8) * (G / 8) + bx / 8 : bx;
    const int NGW = G * NWAVES;
    constexpr int F_UNITS = (MROWS / 256) * (DUP / 256);
    const int f_rem = F_UNITS % G, n_idle = G - f_rem;
    const bool hide_conv = (f_rem != 0) && (n_idle >= 32);
#define PHASE_IDS() int tid_ = threadIdx.x; asm volatile("" : "+v"(tid_)); const int tid = tid_, lane = tid & 63, wave = __builtin_amdgcn_readfirstlane(tid >> 6), gw = vcu * NWAVES + wave; (void)tid; (void)lane; (void)wave; (void)gw

    unsigned char* const ws0 = args.ws;
#define PHASE_PTRS() GAS_ unsigned char* ws = (GAS_ unsigned char*)ws0; asm volatile("" : "+s"(ws)); GAS_ const float* GAS_ const* pt = (GAS_ const float* GAS_ const*)(ws + WS_PTRS); \
    const float* x_in = (const float*)pt[0]; const float* ctx_in = (const float*)pt[2]; const float* norm1_g = (const float*)pt[6]; const float* w_in = (const float*)pt[7]; const float* q_norm_g = (const float*)pt[8]; const float* k_norm_g = (const float*)pt[9]; \
    const float* gmlp_w = (const float*)pt[10]; const float* gmlp_b = (const float*)pt[11]; const float* conv_c_w = (const float*)pt[12]; const float* w_out = (const float*)pt[13]; const float* norm2_g = (const float*)pt[14]; const float* ffn_up = (const float*)pt[15]; \
    const float* ffn_conv_w = (const float*)pt[16]; const float* ffn_down = (const float*)pt[17]; const float* final_g = (const float*)pt[18]; float* out = (float*)pt[19]; \
    float* MODV = (float*)(ws + WS_MODV); f32x2* ROPE = (f32x2*)(ws + WS_ROPE); float* XSC = (float*)(ws + WS_XSC); \
    GAS_ unsigned char* wl_ = ws + ((l & 1) ? WS_W1 : WS_W0); bf16* XB = (bf16*)(ws + WS_XB); (void)XB; bf16* WIN = (bf16*)(wl_ + WO_WIN); bf16* WOUT = (bf16*)(wl_ + WO_WOUT); bf16* WUP = (bf16*)(wl_ + WO_WUP); bf16* WDN = (bf16*)(wl_ + WO_WDN); unsigned* CNT = (unsigned*)(ws + WS_CNT); \
    bf16* ACT = (bf16*)(ws + WS_ACT); bf16* H = (bf16*)(ws + WS_H); float* HALO = (float*)(ws + WS_HALO); \
    bf16* Qb = (bf16*)(ws + WS_Q); bf16* Kb = (bf16*)(ws + WS_K); bf16* Vb = (bf16*)(ws + WS_V); bf16* Ub = (bf16*)(ws + WS_U); \
    bf16* VNb = (bf16*)(ws + WS_VN); bf16* CBb = (bf16*)(ws + WS_CB); bf16* CCHb = (bf16*)(ws + WS_CCH); bf16* MIX = (bf16*)(ws + WS_MIX); \
    const float* modl = MODV + (size_t)l * 3 * 6144; const float* cur_ctx = (l == 0) ? ctx_in : XSC; \
    (void)x_in; (void)ctx_in; (void)norm1_g; (void)w_in; (void)q_norm_g; (void)k_norm_g; (void)gmlp_w; (void)gmlp_b; (void)conv_c_w; (void)w_out; (void)norm2_g; (void)ffn_up; (void)ffn_conv_w; (void)ffn_down; (void)final_g; (void)out; \
    (void)CNT; (void)MODV; (void)ROPE; (void)XSC; (void)WIN; (void)WOUT; (void)WUP; (void)WDN; (void)ACT; (void)H; (void)HALO; (void)Qb; (void)Kb; (void)Vb; (void)Ub; (void)VNb; (void)CBb; (void)CCHb; (void)MIX; (void)modl; (void)cur_ctx
    unsigned char* ws = args.ws;
    if (bx == 0 && threadIdx.x < 20) { const float* p = threadIdx.x < 19 ? args.in[threadIdx.x] : (const float*)args.out; ((const float**)(ws + WS_PTRS))[threadIdx.x] = p; }
    const float* c_in = args.in[1]; const float* cctx_in = args.in[3]; const float* w_mod = args.in[4]; const float* b_mod = args.in[5];
    float* MODV = (float*)(ws + WS_MODV); f32x2* ROPE = (f32x2*)(ws + WS_ROPE);
    unsigned* barw = (unsigned*)(ws + WS_BAR);
    { const int t0 = threadIdx.x;
      for (int u = t0; u < (LDS_BYTES - RING_BYTES) / 4; u += NTHR) ((LAS unsigned*)(lds + RING_BYTES))[u] = 0u;
    }
    __syncthreads();
    const XcdBarrier xbar = xcd_barrier_post(barw, (volatile LAS unsigned*)(lds + RING_BYTES + 64));
#ifndef SKIP_P0
        for (int rep_ = 0; rep_ < REP_P0; ++rep_) { if (rep_) __syncthreads();
        { PHASE_IDS();
    {
        LAS float* sc = (LAS float*)lds;
        LAS float* part = (LAS float*)(lds + 16384);
        for (int i = tid; i < 3072; i += NTHR) { const int s = i >> 10, k = i & 1023; const float cv = s < 2 ? c_in[s * 1024 + k] : cctx_in[k]; sc[i] = silu_f(cv); }
        __syncthreads();
        for (int unit = vcu; unit < NLAYER * 192; unit += G) {
            const int l = unit / 192, j0 = (unit % 192) * 32, hlf = lane >> 5, cl = lane & 31, k0 = wave * 128 + hlf * 64;
            const float* wp = w_mod + (size_t)l * 1024 * 6144 + (size_t)k0 * 6144 + j0 + cl;
            float a0 = 0.f, a1 = 0.f, a2 = 0.f;
#pragma unroll 32
            for (int k = 0; k < 64; ++k) { const float wv = wp[(size_t)k * 6144]; a0 += sc[k0 + k] * wv; a1 += sc[1024 + k0 + k] * wv; a2 += sc[2048 + k0 + k] * wv; }
            a0 += __shfl_xor(a0, 32); a1 += __shfl_xor(a1, 32); a2 += __shfl_xor(a2, 32);
            if (lane < 32) { part[(wave * 3 + 0) * 32 + cl] = a0; part[(wave * 3 + 1) * 32 + cl] = a1; part[(wave * 3 + 2) * 32 + cl] = a2; }
            __syncthreads();
            if (tid < 96) { const int s = tid >> 5, j = tid & 31; float t = b_mod[l * 6144 + j0 + j];
#pragma unroll
                for (int w = 0; w < 8; ++w) t += part[(w * 3 + s) * 32 + j];
                MODV[(size_t)(l * 3 + s) * 6144 + j0 + j] = t; }
            __syncthreads();
        }
        if (bx == 0) {
            for (int e = tid; e < 2048; e += NTHR) {
                const int pos = e >> 4, f = e & 15;
                double th = 1.0; for (int i = 0; i < f; ++i) th *= 0.5623413251903491;
                const double a = (double)pos * th;
                const double kk = __builtin_rint(a * 0.15915494309189535);
                const double xr = (a - kk * 6.283185307179586) - kk * 2.4492935982947064e-16;
                const double x2 = xr * xr; double sn = xr, cs = 1.0, ts = xr, tc = 1.0;
                for (int n = 1; n <= 14; ++n) { tc *= -x2 / (double)((2 * n - 1) * (2 * n)); cs += tc; ts *= -x2 / (double)((2 * n) * (2 * n + 1)); sn += ts; }
                ROPE[e] = (f32x2){(float)cs, (float)sn};
            }
        }
        __syncthreads();
        {
            LAS float* scr = (LAS float*)(lds + wave * 16384);
            const float* w_in = args.in[7]; const float* w_out = args.in[13]; const float* ffn_up = args.in[15]; const float* ffn_down = args.in[17];
            const int nl = 1;
            for (int it = gw; it < nl * CONV_ITEMS; it += NGW) { const int l = it / CONV_ITEMS; convert_item(it - l * CONV_ITEMS, l, w_in, w_out, ffn_up, ffn_down, ws, scr, lane); }
        }
    }
        }
        }
#endif
    if (args.zero) grid.sync();
    xcd_barrier(xbar);

    const bool fused = (G == 256);
    { PHASE_IDS(); const int l = 0; PHASE_PTRS();
      for (int m0 = gw; m0 < MROWS; m0 += 4 * NGW) {
          f32x4 v4[4][4];
#pragma unroll
          for (int q = 0; q < 4; ++q) { const int m = m0 + q * NGW; const int mc = m < MROWS ? m : m0;
              norm_load(mc < NLAT ? x_in + (size_t)mc * 1024 : ctx_in + (size_t)(mc - NLAT) * 1024, lane, v4[q]); }
          asm volatile("" ::: "memory");
#pragma unroll
          for (int q = 0; q < 4; ++q) { const int m = m0 + q * NGW; if (m >= MROWS) continue;
              const int s_ = m < SEQL ? 0 : (m < NLAT ? 1 : 2);
              if (m < NLAT) { v2u* xo = (v2u*)(XB + (size_t)m * 1024) + lane;
#pragma unroll
                  for (int j = 0; j < 4; ++j) { v2u w; w.x = pk2(v4[q][j].x, v4[q][j].y); w.y = pk2(v4[q][j].z, v4[q][j].w); xo[64 * j] = w; } }
              norm_finish(v4[q], norm1_g, modl + (size_t)(s_ * 6 + 0) * 1024, modl + (size_t)(s_ * 6 + 1) * 1024, H + (size_t)m * 1024, lane); }
      }
    }
    xcd_barrier(xbar);
#pragma unroll 1
    for (int l = 0; l < NLAYER; ++l) {
#ifndef SKIP_PB
        for (int rep_ = 0; rep_ < REP_PB; ++rep_) { if (rep_) xcd_barrier(xbar);
        {
            PHASE_PTRS();
            pg8::Gemm g{H, WIN, NLAT, DIN, 1024}; pg8::StaticOrder S; S.init(NLAT, DIN, G, bx);
            pg8::EpiProj E{Qb, Kb, Vb, Ub, VNb, CBb, CCHb, q_norm_g + l * 64, k_norm_g + l * 64, ROPE};
            pg8::gemm_phase<pg8::EpiProj, pg8::StaticOrder, PG8_ALIGN, PG8_SP2>(lds, g, S, E);
        }
        {
            PHASE_IDS(); PHASE_PTRS();
            LAS float* red = (LAS float*)lds;
            for (int tile = vcu; tile < 256; tile += G) {
                const int rtile = tile >> 5, T = (tile >> 2) & 7, wc = tile & 3;
                small_gemm<4, 4>(H + (size_t)(NLAT + 64 * rtile) * 1024, 1024, WIN, [&](int c, int k) { return pg8::wt_off(256 * T + 128 * (c >> 5) + 32 * wc + (c & 31), k, 16, true); }, red, lane, wave);
                __syncthreads();
                const int r = tid >> 3, d0 = (tid & 7) * 8; const int cr = 64 * rtile + r, gm = NLAT + cr;
                float v[8];
#pragma unroll
                for (int k = 0; k < 8; ++k) v[k] = 0.f;
#pragma unroll
                for (int w = 0; w < 8; ++w) { const f32x4 p0 = *(const LAS f32x4*)(red + ((size_t)w * 64 + r) * 64 + d0), p1 = *(const LAS f32x4*)(red + ((size_t)w * 64 + r) * 64 + d0 + 4);
                    v[0] += p0.x; v[1] += p0.y; v[2] += p0.z; v[3] += p0.w; v[4] += p1.x; v[5] += p1.y; v[6] += p1.z; v[7] += p1.w; }
                const int kvb = cr >> 8, kvr = cr & 255;
                float o[8];
                if (T == 0) {
#pragma unroll
                    for (int k = 0; k < 8; ++k) o[k] = gelu_t(v[k]);
                    st8g(Ub + (size_t)gm * 256 + 64 * wc + d0, o);
                } else if (T == 1) {
                    float sm = 0.f;
#pragma unroll
                    for (int k = 0; k < 8; ++k) { v[k] = gelu_t(v[k]); sm += v[k]; }
                    sm += __shfl_xor(sm, 1); sm += __shfl_xor(sm, 2); sm += __shfl_xor(sm, 4);
                    const float mean = sm * (1.f / 64.f); float q = 0.f;
#pragma unroll
                    for (int k = 0; k < 8; ++k) { v[k] -= mean; q += v[k] * v[k]; }
                    q += __shfl_xor(q, 1); q += __shfl_xor(q, 2); q += __shfl_xor(q, 4);
                    const float rstd = rsqrtf(q * (1.f / 64.f) + EPS);
#pragma unroll
                    for (int k = 0; k < 8; ++k) o[k] = v[k] * rstd;
                    st8g(VNb + (size_t)gm * 256 + 64 * wc + d0, o);
                } else if (T == 2 || T == 3 || (T == 4 && wc < 2)) {
                    float ss = 0.f;
#pragma unroll
                    for (int k = 0; k < 8; ++k) ss += v[k] * v[k];
                    ss += __shfl_xor(ss, 1); ss += __shfl_xor(ss, 2); ss += __shfl_xor(ss, 4);
                    const float rr = rsqrtf(ss * (1.f / 64.f) + EPS);
                    const float* gp = (T == 4 ? k_norm_g : q_norm_g) + l * 64 + d0; const float osc = (T == 4) ? 1.f : QSCALE;
#pragma unroll
                    for (int k = 0; k < 8; ++k) o[k] = v[k] * rr * gp[k] * osc;
                    if (T == 4) st8g(Kb + ((((size_t)(kvb * 2 + wc) * (KVROWS / 64) + (kvr >> 6)) * 8 + (d0 >> 3)) * 64 + (kvr & 63)) * 8, o); else st8g(Qb + (size_t)gm * 512 + 64 * (4 * (T - 2) + wc) + d0, o);
                } else if (T == 4) {
                    st8g(Vb + ((((size_t)(kvb * 2 + wc - 2) * (KVROWS / 64) + (kvr >> 6)) * 8 + ((d0 >> 5) * 4 + ((kvr >> 4) & 3))) * 16 + (kvr & 15)) * 32 + (d0 & 31), v);
                } else if (T == 5) {
                    st8g(CBb + (size_t)gm * 256 + 64 * wc + d0, v);
                } else {
#pragma unroll
                    for (int k = 0; k < 8; ++k) o[k] = v[k] * __shfl_xor(v[k], 4);
                    if (d0 < 32) st8g(CCHb + (size_t)gm * 256 + 128 * (T - 6) + 32 * wc + d0, o);
                }
                __syncthreads();
            }
        }
        }
#endif
        xcd_barrier(xbar);
#ifndef SKIP_PC
        for (int rep_ = 0; rep_ < REP_PC; ++rep_) { if (rep_) xcd_barrier(xbar);
        { PHASE_IDS(); PHASE_PTRS();
        {
            float gqm = fabsf(q_norm_g[l * 64 + lane]), gkm = fabsf(k_norm_g[l * 64 + lane]);
#pragma unroll
            for (int o = 1; o < 64; o <<= 1) { gqm = fmaxf(gqm, __shfl_xor(gqm, o)); gkm = fmaxf(gkm, __shfl_xor(gkm, o)); }
            const float mstat = __builtin_amdgcn_readfirstlane(64.f * QSCALE * 1.01f * gqm * gkm);
            const bool use_static = mstat <= 30.f;
            for (int i = 0;; ++i) {
                const int u = vcu + i * G; if (u >= (l == NLAYER - 1 ? 512 : 528)) break;
                const attn_body::bf16 *Qu, *Kh, *Vh; attn_body::bf16* Ou; int NT;
                if (u < 512) { const int bg = u >> 7, b = bg >> 1, g = bg & 1, rem = u & 127, qh = g * 4 + (rem >> 5), qb = rem & 31;
                    const size_t r0 = (size_t)b * SEQL + qb * 256;
                    Qu = (const attn_body::bf16*)Qb + r0 * 512 + qh * 64; Ou = (attn_body::bf16*)MIX + r0 * 1024 + 256 + qh * 64;
                    Kh = (const attn_body::bf16*)Kb + (size_t)(b * 2 + g) * (KVROWS / 64) * 4096; Vh = (const attn_body::bf16*)Vb + (size_t)(b * 2 + g) * (KVROWS / 64) * 4096; NT = KVROWS / 64;
                } else { const int j = u - 512, b = j >> 3, qh = j & 7, g = qh >> 2;
                    const size_t r0 = (size_t)NLAT + b * CTXL;
                    Qu = (const attn_body::bf16*)Qb + r0 * 512 + qh * 64; Ou = (attn_body::bf16*)MIX + r0 * 1024 + 256 + qh * 64;
                    Kh = (const attn_body::bf16*)Kb + (size_t)(b * 2 + g) * (KVROWS / 64) * 4096; Vh = (const attn_body::bf16*)Vb + (size_t)(b * 2 + g) * (KVROWS / 64) * 4096; NT = CTXL / 64;
                }
                if (use_static) attn_body::attn_unit<8, true>(Qu, 512, Kh, Vh, 128, NT, Ou, 1024, (char*)lds_raw, mstat);
                else attn_body::attn_unit<8, false>(Qu, 512, Kh, Vh, 128, NT, Ou, 1024, (char*)lds_raw, 0.f);
            }
            __syncthreads();
            {
                constexpr int VP = 72;
                LAS bf16* vt = (LAS bf16*)lds;
                for (int unit = (vcu + G / 2) % G; unit < ((l == NLAYER - 1 ? NLAT : MROWS) / 128) * 4; unit += G) {
                    const int ck = unit >> 2, h = unit & 3, m0 = ck * 128;
                    const int pi = lane & 15, kq = lane >> 4, p = wave * 16 + pi;
                    const float* wrow = gmlp_w + ((size_t)(l * 4 + h) * 128 + p) * 128;
                    const int trow = tid >> 2, chk = tid & 3; const bf16* src = VNb + (size_t)(m0 + trow) * 256 + h * 64 + chk * 16;
                    const v4u ta = *(const v4u*)src, tb = *(const v4u*)(src + 8);
                    f32x4 wf[4][2];
#pragma unroll
                    for (int ks = 0; ks < 4; ++ks) { wf[ks][0] = *(const f32x4*)(wrow + 32 * ks + 8 * kq); wf[ks][1] = *(const f32x4*)(wrow + 32 * ks + 8 * kq + 4); }
                    const float bias = gmlp_b[(l * 4 + h) * 128 + p];
                    v2u ug[4];
#pragma unroll
                    for (int nt = 0; nt < 4; ++nt) ug[nt] = *(const v2u*)(Ub + (size_t)(m0 + p) * 256 + h * 64 + 16 * nt + 4 * kq);
                    *(LAS v4u*)(vt + trow * VP + chk * 16) = ta; *(LAS v4u*)(vt + trow * VP + chk * 16 + 8) = tb;
                    __syncthreads();
                    bf16x8 bfr[4];
#pragma unroll
                    for (int ks = 0; ks < 4; ++ks) { const f32x4 w0 = wf[ks][0], w1 = wf[ks][1];
                        v4u t; t.x = pk2(w0.x, w0.y); t.y = pk2(w0.z, w0.w); t.z = pk2(w1.x, w1.y); t.w = pk2(w1.z, w1.w); bfr[ks] = __builtin_bit_cast(bf16x8, t); }
#pragma unroll
                    for (int nt = 0; nt < 4; ++nt) {
                        f32x4 d = {0.f, 0.f, 0.f, 0.f};
#pragma unroll
                        for (int ks = 0; ks < 4; ++ks) { bf16x8 af;
#pragma unroll
                            for (int jj = 0; jj < 8; ++jj) af[jj] = (short)vt[(32 * ks + 8 * kq + jj) * VP + 16 * nt + pi];
                            d = __builtin_amdgcn_mfma_f32_16x16x32_bf16(af, bfr[ks], d, 0, 0, 0); }
                        const size_t row = (size_t)(m0 + p); const int dc = h * 64 + 16 * nt + 4 * kq;
                        const v2u uu = ug[nt];
                        v2u o; o.x = pk2(bf_lo(uu.x) * (d[0] + bias), bf_hi(uu.x) * (d[1] + bias)); o.y = pk2(bf_lo(uu.y) * (d[2] + bias), bf_hi(uu.y) * (d[3] + bias));
                        *(v2u*)(MIX + row * 1024 + dc) = o;
                    }
                    __syncthreads();
                }
            }
            {
                const f32x4 w0 = ((const f32x4*)(conv_c_w + (size_t)l * 768))[lane], w1 = ((const f32x4*)(conv_c_w + (size_t)l * 768 + 256))[lane], w2 = ((const f32x4*)(conv_c_w + (size_t)l * 768 + 512))[lane];
                const int rows_per = (MROWS + G - 1) / G;
                constexpr int CU_ = 4;
                for (int i0 = wave; i0 < rows_per; i0 += NWAVES * CU_) {
                    v2u cm[CU_], cp[CU_], cn[CU_], cb[CU_]; int mm[CU_];
#pragma unroll
                    for (int u = 0; u < CU_; ++u) {
                        const int i = i0 + NWAVES * u; int m = vcu * rows_per + i; if (i >= rows_per || m >= (l == NLAYER - 1 ? NLAT : MROWS)) m = -1;
                        mm[u] = m; const int mc = m < 0 ? 0 : m;
                        const int t = mc < NLAT ? (mc & (SEQL - 1)) : ((mc - NLAT) & (CTXL - 1)); const int L = mc < NLAT ? SEQL : CTXL;
                        const v2u z = {0u, 0u};
                        cm[u] = *(const v2u*)(CCHb + (size_t)mc * 256 + 4 * lane);
                        cp[u] = t > 0 ? *(const v2u*)(CCHb + (size_t)(mc - 1) * 256 + 4 * lane) : z;
                        cn[u] = t < L - 1 ? *(const v2u*)(CCHb + (size_t)(mc + 1) * 256 + 4 * lane) : z;
                        cb[u] = *(const v2u*)(CBb + (size_t)mc * 256 + 4 * lane);
                    }
#pragma unroll
                    for (int u = 0; u < CU_; ++u) {
                        if (mm[u] < 0) continue;
                        const float o0 = bf_lo(cb[u].x) * (w0.x * bf_lo(cp[u].x) + w1.x * bf_lo(cm[u].x) + w2.x * bf_lo(cn[u].x));
                        const float o1 = bf_hi(cb[u].x) * (w0.y * bf_hi(cp[u].x) + w1.y * bf_hi(cm[u].x) + w2.y * bf_hi(cn[u].x));
                        const float o2 = bf_lo(cb[u].y) * (w0.z * bf_lo(cp[u].y) + w1.z * bf_lo(cm[u].y) + w2.z * bf_lo(cn[u].y));
                        const float o3 = bf_hi(cb[u].y) * (w0.w * bf_hi(cp[u].y) + w1.w * bf_hi(cm[u].y) + w2.w * bf_hi(cn[u].y));
                        v2u o; o.x = pk2(o0, o1); o.y = pk2(o2, o3);
                        *(v2u*)(MIX + (size_t)mm[u] * 1024 + 768 + 4 * lane) = o;
                    }
                }
            }
        }
        }
        }
#endif
        xcd_barrier(xbar);
#ifndef SKIP_PD
        {
            PHASE_PTRS();
            pg8::Gemm g{MIX, WOUT, NLAT, 1024, 1024}; pg8::StaticOrder S; S.init(NLAT, 1024, G, bx);
            pg8::EpiResid E{XB, XB, modl, 2};
            pg8::gemm_phase<pg8::EpiResid, pg8::StaticOrder, PG8_ALIGN, PG8_SP2>(lds, g, S, E);
        }
        {
            PHASE_IDS(); PHASE_PTRS();
            LAS float* red = (LAS float*)lds;
            for (int tile = vcu; tile < (l == NLAYER - 1 ? 0 : 256); tile += G) {
                const int rtile = tile >> 4, ctile = tile & 15;
                small_gemm<2, 4>(MIX + (size_t)(NLAT + 32 * rtile) * 1024, 1024, WOUT, [&](int c, int k) { return pg8::wt_off(64 * ctile + c, k, 16, true); }, red, lane, wave);
                __syncthreads();
                const int r = tid >> 4, c0 = (tid & 15) * 4; const int cr = 32 * rtile + r, col = 64 * ctile + c0;
                f32x4 v = {0.f, 0.f, 0.f, 0.f};
#pragma unroll
                for (int w = 0; w < 8; ++w) v += *(const LAS f32x4*)(red + ((size_t)w * 32 + r) * 64 + c0);
                const f32x4 gt = *(const f32x4*)(modl + (size_t)(2 * 6 + 2) * 1024 + col);
                const f32x4 b = *(const f32x4*)(cur_ctx + (size_t)cr * 1024 + col);
                *(f32x4*)(XSC + (size_t)cr * 1024 + col) = b + gt * v;
                __syncthreads();
            }
        }
        if (fused) { PHASE_IDS(); PHASE_PTRS();
            pg8::StaticOrder S2; S2.init(NLAT, 1024, G, bx); pg8::Unit u2; (void)S2.next(0, u2);
            panel_norm(CNT + (l * 2 + 0) * 128, u2.pm, u2.pn, vcu, XB, out, XSC, norm2_g + l * 1024, modl, 3, 4, H, false, l < NLAYER - 1, tid, lane, wave);
        }
#endif
        xcd_barrier(xbar);
        if (!fused) { { PHASE_IDS(); PHASE_PTRS(); NORM_ROWS(XB, XSC, norm2_g + l * 1024, modl, 3, 4); } xcd_barrier(xbar); }
#ifndef SKIP_PF
        for (int rep_ = 0; rep_ < REP_PF; ++rep_) { if (rep_) xcd_barrier(xbar);
        {
            PHASE_PTRS();
            const int mf = (l == NLAYER - 1) ? NLAT : MROWS;
            pg8::Gemm g{H, WUP, mf, DUP, 1024}; pg8::StaticOrder S; S.init(mf, DUP, G, bx);
            pg8::EpiUpConv E{ACT, HALO, ffn_conv_w + (size_t)l * 3 * DUP};
            pg8::gemm_phase<pg8::EpiUpConv, pg8::StaticOrder, PG8_ALIGN, PG8_SP2>(lds, g, S, E);
            if (hide_conv && l + 1 < NLAYER && bx >= f_rem) {
                PHASE_IDS(); LAS float* scr = (LAS float*)(lds + wave * 16384);
                for (int it = (bx - f_rem) * NWAVES + wave; it < CONV_ITEMS; it += n_idle * NWAVES) convert_item(it, l + 1, w_in, w_out, ffn_up, ffn_down, (unsigned char*)ws, scr, lane);
            }
            if (!hide_conv && l + 1 < NLAYER) { PHASE_IDS(); LAS float* scr = (LAS float*)(lds + wave * 16384);
                for (int it = gw; it < CONV_ITEMS; it += NGW) convert_item(it, l + 1, w_in, w_out, ffn_up, ffn_down, (unsigned char*)ws, scr, lane); }
        }
        }
#endif
        xcd_barrier(xbar);
#ifndef SKIP_PG
        { PHASE_IDS(); PHASE_PTRS();
            const float* cw = ffn_conv_w + (size_t)l * 3 * DUP;
            for (int tk = gw; tk < 11 * 2 * ((l == NLAYER - 1 ? NLAT : MROWS) / 128 - 1); tk += NGW) {
                const int task = tk / 11, it = tk - 11 * task; const int S = 1 + (task >> 1), which = task & 1, R = 128 * S;
                const bool boundary = R < NLAT ? ((R & (SEQL - 1)) == 0) : (((R - NLAT) & (CTXL - 1)) == 0);
                if (boundary) continue;
                const float* hp = HALO + (size_t)((S - 1) * 4 + 2 + which) * DUP;
                const int row = R - 1 + which;
                {
                    const int c = 4 * (lane + 64 * it);
                    const f32x4 ap = *(const f32x4*)(hp + c), am = *(const f32x4*)(hp + DUP + c), an = *(const f32x4*)(hp + 2 * DUP + c);
                    const f32x4 gp = *(const f32x4*)(hp + DFF + c), gmv = *(const f32x4*)(hp + DUP + DFF + c), gn = *(const f32x4*)(hp + 2 * DUP + DFF + c);
                    const f32x4 wa0 = *(const f32x4*)(cw + c), wa1 = *(const f32x4*)(cw + DUP + c), wa2 = *(const f32x4*)(cw + 2 * DUP + c);
                    const f32x4 wg0 = *(const f32x4*)(cw + DFF + c), wg1 = *(const f32x4*)(cw + DUP + DFF + c), wg2 = *(const f32x4*)(cw + 2 * DUP + DFF + c);
                    const f32x4 ca = wa0 * ap + wa1 * am + wa2 * an, cg = wg0 * gp + wg1 * gmv + wg2 * gn;
                    v2u o; o.x = pk2(silu_f(cg.x) * ca.x, silu_f(cg.y) * ca.y); o.y = pk2(silu_f(cg.z) * ca.z, silu_f(cg.w) * ca.w);
                    *(v2u*)(ACT + (size_t)row * DFF + c) = o;
                }
            }
        }
#endif
        xcd_barrier(xbar);
#ifndef SKIP_PH
        {
            PHASE_PTRS();
            pg8::Gemm g{ACT, WDN, NLAT, 1024, DFF}; pg8::StaticOrder S; S.init(NLAT, 1024, G, bx);
            pg8::EpiResid E{XB, XB, modl, 5};
            pg8::gemm_phase<pg8::EpiResid, pg8::StaticOrder, PG8_ALIGN, PG8_SP2>(lds, g, S, E);
        }
        {
            PHASE_IDS(); PHASE_PTRS();
            LAS float* red = (LAS float*)lds;
            for (int tile = vcu; tile < (l == NLAYER - 1 ? 0 : 256); tile += G) {
                const int rtile = tile >> 4, ctile = tile & 15;
                small_gemm<2, 11>(ACT + (size_t)(NLAT + 32 * rtile) * 2816, 2816, WDN, [&](int c, int k) { return pg8::wt_off(64 * ctile + c, k, 44, true); }, red, lane, wave);
                __syncthreads();
                const int r = tid >> 4, c0 = (tid & 15) * 4; const int cr = 32 * rtile + r, col = 64 * ctile + c0;
                f32x4 v = {0.f, 0.f, 0.f, 0.f};
#pragma unroll
                for (int w = 0; w < 8; ++w) v += *(const LAS f32x4*)(red + ((size_t)w * 32 + r) * 64 + c0);
                const f32x4 gt = *(const f32x4*)(modl + (size_t)(2 * 6 + 5) * 1024 + col);
                const f32x4 b = *(const f32x4*)(XSC + (size_t)cr * 1024 + col);
                *(f32x4*)(XSC + (size_t)cr * 1024 + col) = b + gt * v;
                __syncthreads();
            }
        }
        if (fused) { PHASE_IDS(); PHASE_PTRS();
            pg8::StaticOrder S2; S2.init(NLAT, 1024, G, bx); pg8::Unit u2; (void)S2.next(0, u2);
            const bool fin = (l == NLAYER - 1); const int ln = fin ? l : l + 1;
            panel_norm(CNT + (l * 2 + 1) * 128, u2.pm, u2.pn, vcu, XB, out, XSC, fin ? final_g : norm1_g + ln * 1024, MODV + (size_t)ln * 3 * 6144, 0, 1, H, fin, !fin, tid, lane, wave);
        }
#endif
        if (fused && l == NLAYER - 1) break;
        xcd_barrier(xbar);
        if (!fused) { PHASE_IDS(); PHASE_PTRS();
            if (l < NLAYER - 1) { NORM_ROWS(XB, XSC, norm1_g + (l + 1) * 1024, MODV + (size_t)(l + 1) * 3 * 6144, 0, 1); }
            else {
                for (int m = gw; m < NLAT; m += NGW) { f32x4 va[4]; norm_load_bf(XB + (size_t)m * 1024, lane, va); final_finish(va, final_g, out + (size_t)m * 1024, lane); }
            }
            if (l < NLAYER - 1) xcd_barrier(xbar);
        }
    }
}

extern "C" void kernel_launch(void* const* d_in, const int* in_sizes, int n_in, void* d_out, int out_size, void* d_ws, size_t ws_size, hipStream_t stream) {
    static int grid = 0;
    if (grid == 0) {
        if (n_in != 19 || out_size != NLAT * DMOD || ws_size < WS_END) { fprintf(stderr, "kernel_launch: unexpected shapes (n_in %d out %d ws %zu need %zu)\n", n_in, out_size, ws_size, (size_t)WS_END); grid = -1; return; }
        int dev = 0, cus = 0, per_cu = 0;
        hipGetDevice(&dev); hipDeviceGetAttribute(&cus, hipDeviceAttributeMultiprocessorCount, dev);
        if (hipFuncSetAttribute((const void*)fwd_megakernel, hipFuncAttributeMaxDynamicSharedMemorySize, LDS_BYTES) != hipSuccess) { fprintf(stderr, "kernel_launch: hipFuncSetAttribute failed\n"); grid = -1; return; }
        if (hipOccupancyMaxActiveBlocksPerMultiprocessor(&per_cu, (const void*)fwd_megakernel, NTHR, LDS_BYTES) != hipSuccess || per_cu < 1) { fprintf(stderr, "kernel_launch: occupancy query says %d\n", per_cu); per_cu = 1; }
        (void)hipGetLastError();
        grid = cus;
    }
    if (grid < 0) return;
    if (hipMemsetAsync((char*)d_ws + WS_BAR, 0, WS_CNT + 4096 - WS_BAR, stream) != hipSuccess) { fprintf(stderr, "kernel_launch: hipMemsetAsync failed\n"); return; }
    Args a{};
    for (int i = 0; i < 19; ++i) a.in[i] = (const float*)d_in[i];
    a.out = (float*)d_out; a.ws = (unsigned char*)d_ws;
    void* kargs[] = {&a};
    hipError_t e = hipLaunchCooperativeKernel((const void*)fwd_megakernel, dim3(grid), dim3(NTHR), kargs, LDS_BYTES, stream);
    if (e != hipSuccess) fprintf(stderr, "kernel_launch: cooperative launch failed: %s (grid %d)\n", hipGetErrorString(e), grid);
}
```

```cpp
#include <hip/hip_runtime.h>
#include <cstdio>
#include <cstdint>
namespace pg8 {
#define PG8_LAS __attribute__((address_space(3)))
typedef unsigned short bf16_t;
typedef short bf16x8 __attribute__((ext_vector_type(8)));
typedef float f32x4 __attribute__((ext_vector_type(4)));
typedef unsigned u32x4 __attribute__((ext_vector_type(4)));
constexpr int BM = 256, BK = 64, HALF = 128, HTB = HALF * BK * 2  , STAGE_BYTES = 8 * HTB, NXCD = 8, WGM = 8;

__host__ __device__ __forceinline__ int lds_byte(int r, int c) { const int st = (r >> 4) * 2 + (c >> 5), rr = r & 15, cc = c & 31, ob = rr * 64 + cc * 2; return st * 1024 + (ob ^ (((ob >> 9) & 1) << 5)); }
__host__ __device__ __forceinline__ void stage_rc(int b, int& R, int& C) { const int st = b / 1024, sb = b % 1024, swz = sb ^ (((sb >> 9) & 1) << 5); R = (st >> 1) * 16 + swz / 64; C = (st & 1) * 32 + (swz % 64) / 2; }
__host__ __device__ __forceinline__ int perm32(int rho) { const int n = rho >> 4, i = rho & 15; return 8 * (i >> 2) + 4 * n + (i & 3); }

__host__ __device__ __forceinline__ size_t wt_off(int P, int k, int nt, bool perm) {
    const int p = P & 127, x = p & 31, R = perm ? ((p & ~31) + 16 * ((x >> 2) & 1) + 4 * (x >> 3) + (x & 3)) : p;
    return ((size_t)(((P >> 8) * nt + (k >> 6)) * 2 + ((P >> 7) & 1)) * 16384 + (size_t)lds_byte(R, k & 63)) >> 1;
}
struct Unit { int pm, pn; };
struct Gemm { const bf16_t* A; const bf16_t* Bt; int M, N, K; };

struct StaticOrder {
    int nM, nN, nwg, G, c;
    __host__ __device__ __forceinline__ void init(int M, int N, int G_, int c_) { nM = M / BM; nN = N / BM; nwg = nM * nN; G = G_; c = c_; }
    __host__ __device__ __forceinline__ bool next(int i, Unit& u) const {
        const long L = (long)i * G + c; if (L >= nwg) return false;
        int wgid = (int)L; { const int q = nwg / NXCD, r = nwg % NXCD, xcd = wgid % NXCD, off = wgid / NXCD; wgid = (xcd < r ? xcd * (q + 1) : r * (q + 1) + (xcd - r) * q) + off; }
        const int nig = WGM * nN, gid = wgid / nig, fm = gid * WGM, gsz = (nM - fm) < WGM ? (nM - fm) : WGM;
        u.pm = fm + ((wgid % nig) % gsz); u.pn = (wgid % nig) / gsz; return true;
    }
    __device__ __forceinline__ void a_ready(const Unit&) const {}
    __device__ __forceinline__ void done(const Unit&) const {}
};

__device__ __forceinline__ unsigned cvt_pk_bf16(float lo, float hi) { unsigned r; asm volatile("v_cvt_pk_bf16_f32 %0, %1, %2" : "=v"(r) : "v"(lo), "v"(hi)); return r; }
typedef float f32x2 __attribute__((ext_vector_type(2)));
__device__ __forceinline__ f32x2 gelu_pk(f32x2 v) {
    const f32x2 av = __builtin_elementwise_abs(v), d = av * 0.2316418882f + 1.0f;
    f32x2 t; t.x = __builtin_amdgcn_rcpf(d.x); t.y = __builtin_amdgcn_rcpf(d.y);
    f32x2 q = t * 0.5307027145f + (-0.7265760135f); q = q * t + 0.7107068705f; q = q * t + (-0.142248368f); q = q * t + 0.127414796f; q = q * t;
    const f32x2 s = (v * v) * (-0.72134752044f);
    f32x2 e; e.x = __builtin_amdgcn_exp2f(s.x); e.y = __builtin_amdgcn_exp2f(s.y);
    const f32x2 m = v * (q * e), r = v - m;
    f32x2 o; o.x = v.x < 0.f ? m.x : r.x; o.y = v.y < 0.f ? m.y : r.y; return o;
}

template <int ACT  > struct EpiBf16 {
    static constexpr bool PERM = true, AFTER_DRAIN = false, ROWPERM = false; static_assert(ACT == 0 || ACT == 1, "EpiBf16: ACT is 0 (none) or 1 (gelu_pk)");
    bf16_t* O; int ldc; const float* bias; int split_cols; size_t split_stride; float scale0;
    __device__ __forceinline__ void operator()(const f32x4 (&acc)[2][2][4][2], const Unit& u, int wr, int wc, int fr, int fq) const {
        const int row0 = u.pm * BM + wr * 64 + fr; int colt = u.pn * BM; bf16_t* base = O;
        float sc = 1.f; if (split_cols) { const int t = colt / split_cols; base += (size_t)t * split_stride; colt -= t * split_cols; if (t == 0) sc = scale0; }
        const int col0 = colt + wc * 32 + 8 * fq, bcol0 = u.pn * BM + wc * 32 + 8 * fq;
        f32x4 bv[2][2];
#pragma unroll
        for (int bj = 0; bj < 2; ++bj)
#pragma unroll
            for (int n = 0; n < 2; ++n) bv[bj][n] = bias ? *(const f32x4*)(bias + bcol0 + bj * HALF + 4 * n) : (f32x4){0.f, 0.f, 0.f, 0.f};
#pragma unroll
        for (int ai = 0; ai < 2; ++ai)
#pragma unroll
            for (int m = 0; m < 4; ++m) { bf16_t* rowp = base + (size_t)(row0 + ai * HALF + m * 16) * ldc + col0;
#pragma unroll
                for (int bj = 0; bj < 2; ++bj) { f32x4 v0 = acc[ai][bj][m][0] + bv[bj][0], v1 = acc[ai][bj][m][1] + bv[bj][1];
                    if (ACT == 1) { f32x2 a = gelu_pk((f32x2){v0[0], v0[1]}), b = gelu_pk((f32x2){v0[2], v0[3]}), c = gelu_pk((f32x2){v1[0], v1[1]}), d = gelu_pk((f32x2){v1[2], v1[3]});
                        v0 = (f32x4){a.x, a.y, b.x, b.y}; v1 = (f32x4){c.x, c.y, d.x, d.y}; }
                    v0 = v0 * sc; v1 = v1 * sc; u32x4 w; w.x = cvt_pk_bf16(v0[0], v0[1]); w.y = cvt_pk_bf16(v0[2], v0[3]); w.z = cvt_pk_bf16(v1[0], v1[1]); w.w = cvt_pk_bf16(v1[2], v1[3]);
                    *(u32x4*)(rowp + bj * HALF) = w; } }
    }
};

template <class Epi, class Sched, bool ALIGN_EPI = false, bool SP2 = false>
__device__ __forceinline__ void gemm_phase(PG8_LAS unsigned char* lds, const Gemm g, const Sched& S, const Epi& E) {
    int tid_ = threadIdx.x; asm volatile("" : "+v"(tid_));
    const int tid = tid_, wid = __builtin_amdgcn_readfirstlane(tid >> 6), lane = tid & 63, wr = wid >> 2, wc = wid & 3, fr = lane & 15, fq = lane >> 4;
    const int K = g.K, nt = K / BK;
    unsigned voffA, voffB;
    { int R, C; stage_rc(tid * 16, R, C); const int Rb = Epi::PERM ? ((R & ~31) + perm32(R & 31)) : R; const int Ra = Epi::ROWPERM ? (8 * (R & 15) + ((R >> 4) & 3)) : R;
        voffA = (unsigned)(Ra * K + C) * 2u; voffB = (unsigned)tid * 16u; (void)Rb; }
    const size_t rstepB = 8192, rstepA = Epi::ROWPERM ? (size_t)128 * K * 2 : (size_t)64 * K * 2;
    const size_t kstep = (size_t)(BK * 2);
    const size_t hstep = (size_t)HALF * K * 2; const size_t hstepA = Epi::ROWPERM ? (size_t)4 * K * 2 : hstep;
    const size_t tstep = 2 * hstep;
    const size_t hstepB = 16384, kstepB = 32768, tstepB = (size_t)nt * 32768;
    const unsigned ldsw = (unsigned)wid * 1024u;
    const int aoff = lds_byte(wr * 64 + fr, fq * 8), boff = lds_byte(wc * 32 + fr, fq * 8);
#define PG8_SA(b, h) (((b) * 2 + (h)) * HTB)
#define PG8_SB(b, h) ((4 + (b) * 2 + (h)) * HTB)
#define PG8_STAGE(bufoff, gbase, voff, rstep64) do { _Pragma("unroll") for (int _i = 0; _i < 2; ++_i) \
        __builtin_amdgcn_global_load_lds((const unsigned*)((const char*)(gbase) + (size_t)_i * rstep64 + (voff)), (PG8_LAS unsigned*)(lds + (bufoff) + ldsw + _i * 8192), 16, 0, 0); } while (0)
#define PG8_LDA(dst, b, h) do { _Pragma("unroll") for (int m = 0; m < 4; ++m) _Pragma("unroll") for (int k = 0; k < 2; ++k) dst[m][k] = *(const PG8_LAS bf16x8*)(lds + PG8_SA(b, h) + aoff + m * 2048 + k * 1024); } while (0)
#define PG8_LDB(dst, b, h) do { _Pragma("unroll") for (int n = 0; n < 2; ++n) _Pragma("unroll") for (int k = 0; k < 2; ++k) dst[n][k] = *(const PG8_LAS bf16x8*)(lds + PG8_SB(b, h) + boff + n * 2048 + k * 1024); } while (0)
#define PG8_MMA(ai, bj, At, Bt) do { __builtin_amdgcn_s_setprio(1); _Pragma("unroll") for (int m = 0; m < 4; ++m) _Pragma("unroll") for (int n = 0; n < 2; ++n) _Pragma("unroll") for (int k = 0; k < 2; ++k) \
        acc[ai][bj][m][n] = __builtin_amdgcn_mfma_f32_16x16x32_bf16(Bt[n][k], At[m][k], acc[ai][bj][m][n], 0, 0, 0); __builtin_amdgcn_s_setprio(0); } while (0)
#define PG8_WAIT_V(n) asm volatile("s_waitcnt vmcnt(" #n ")" ::: "memory")
#define PG8_WAIT_L(n) asm volatile("s_waitcnt lgkmcnt(" #n ")" ::: "memory")
#define PG8_BAR __builtin_amdgcn_s_barrier()
#define PG8_SCHED __builtin_amdgcn_sched_barrier(0)
    Unit cur, nxt; int ui = 0;
    if (!S.next(0, cur)) return;
    f32x4 acc[2][2][4][2];
#pragma unroll
    for (int a = 0; a < 2; ++a)
#pragma unroll
        for (int b = 0; b < 2; ++b)
#pragma unroll
            for (int m = 0; m < 4; ++m)
#pragma unroll
                for (int n = 0; n < 2; ++n) acc[a][b][m][n] = (f32x4){0.f, 0.f, 0.f, 0.f};
    bf16x8 At[4][2], B0[2][2], B1[2][2];
    const char* cA = (const char*)g.A + (size_t)cur.pm * tstep; const char* cB = (const char*)g.Bt + (size_t)cur.pn * tstepB;
    S.a_ready(cur);
    if constexpr (SP2) {
        PG8_STAGE(PG8_SB(0, 0), cB, voffB, rstepB); PG8_STAGE(PG8_SB(0, 1), cB + hstepB, voffB, rstepB); PG8_STAGE(PG8_SA(0, 0), cA, voffA, rstepA); PG8_STAGE(PG8_SA(0, 1), cA + hstepA, voffA, rstepA);
        if (wr == 1) PG8_BAR;
        PG8_WAIT_V(2); PG8_BAR;
        PG8_STAGE(PG8_SB(1, 0), cB + kstepB, voffB, rstepB); PG8_STAGE(PG8_SA(1, 0), cA + kstep, voffA, rstepA); PG8_STAGE(PG8_SB(1, 1), cB + hstepB + kstepB, voffB, rstepB);
        PG8_WAIT_V(6); PG8_BAR;
    } else {
        PG8_STAGE(PG8_SB(0, 0), cB, voffB, rstepB); PG8_STAGE(PG8_SA(0, 0), cA, voffA, rstepA); PG8_STAGE(PG8_SB(0, 1), cB + hstepB, voffB, rstepB); PG8_STAGE(PG8_SA(0, 1), cA + hstepA, voffA, rstepA);
        if (wr == 1) PG8_BAR;
        PG8_WAIT_V(4); PG8_BAR;
        PG8_STAGE(PG8_SB(1, 0), cB + kstepB, voffB, rstepB); PG8_STAGE(PG8_SA(1, 0), cA + kstep, voffA, rstepA); PG8_STAGE(PG8_SB(1, 1), cB + hstepB + kstepB, voffB, rstepB);
        PG8_WAIT_V(6); PG8_BAR;
    }
    for (;;) {
        const bool has_next = S.next(ui + 1, nxt);
        const char* nA = has_next ? (const char*)g.A + (size_t)nxt.pm * tstep : cA; const char* nB = has_next ? (const char*)g.Bt + (size_t)nxt.pn * tstepB : cB;
        for (int t = 0; t < nt; t += 2) {
            const bool last = (t == nt - 2);
            const char* a1 = cA + (size_t)(t + 1) * kstep;
            const char* a2 = last ? nA : cA + (size_t)(t + 2) * kstep; const char* b2 = last ? nB : cB + (size_t)(t + 2) * kstepB;
            const char* a3 = a2 + kstep; const char* b3 = b2 + kstepB;
            if (last && has_next) S.a_ready(nxt);
            if constexpr (SP2) {
            PG8_LDB(B0, 0, 0); PG8_LDB(B1, 0, 1); PG8_SCHED; PG8_LDA(At, 0, 0); PG8_STAGE(PG8_SA(1, 1), a1 + hstepA, voffA, rstepA);
            PG8_WAIT_V(8); PG8_WAIT_L(0); PG8_BAR; PG8_MMA(0, 0, At, B0); PG8_MMA(0, 1, At, B1); PG8_BAR; PG8_SCHED;
            PG8_LDA(At, 0, 1); PG8_STAGE(PG8_SB(0, 0), b2, voffB, rstepB); PG8_STAGE(PG8_SB(0, 1), b2 + hstepB, voffB, rstepB); PG8_STAGE(PG8_SA(0, 0), a2, voffA, rstepA);
            PG8_WAIT_V(8); PG8_WAIT_L(0); PG8_BAR; PG8_MMA(1, 0, At, B0); PG8_MMA(1, 1, At, B1); PG8_BAR; PG8_SCHED;
            PG8_LDB(B0, 1, 0); PG8_LDB(B1, 1, 1); PG8_SCHED; PG8_LDA(At, 1, 0); PG8_STAGE(PG8_SA(0, 1), a2 + hstepA, voffA, rstepA);
            PG8_WAIT_V(8); PG8_WAIT_L(0); PG8_BAR; PG8_MMA(0, 0, At, B0); PG8_MMA(0, 1, At, B1); PG8_BAR; PG8_SCHED;
            PG8_LDA(At, 1, 1); PG8_STAGE(PG8_SB(1, 0), b3, voffB, rstepB); PG8_STAGE(PG8_SB(1, 1), b3 + hstepB, voffB, rstepB); PG8_STAGE(PG8_SA(1, 0), a3, voffA, rstepA);
            PG8_WAIT_V(8); PG8_WAIT_L(0); PG8_BAR; PG8_MMA(1, 0, At, B0); PG8_MMA(1, 1, At, B1); PG8_BAR; PG8_SCHED;
            } else {
            PG8_LDB(B0, 0, 0); PG8_SCHED; PG8_LDA(At, 0, 0); PG8_STAGE(PG8_SA(1, 1), a1 + hstepA, voffA, rstepA);
            PG8_WAIT_L(8); PG8_BAR; PG8_WAIT_L(0); PG8_MMA(0, 0, At, B0); PG8_BAR; PG8_SCHED;
            PG8_LDB(B1, 0, 1); PG8_STAGE(PG8_SB(0, 0), b2, voffB, rstepB);
            PG8_BAR; PG8_WAIT_L(0); PG8_MMA(0, 1, At, B1); PG8_BAR;
            PG8_LDA(At, 0, 1); PG8_STAGE(PG8_SA(0, 0), a2, voffA, rstepA);
            PG8_BAR; PG8_WAIT_L(0); PG8_MMA(1, 0, At, B0); PG8_BAR; PG8_SCHED;
            PG8_STAGE(PG8_SB(0, 1), b2 + hstepB, voffB, rstepB);
            PG8_WAIT_V(6); PG8_BAR; PG8_MMA(1, 1, At, B1); PG8_BAR;
            PG8_LDB(B0, 1, 0); PG8_SCHED; PG8_LDA(At, 1, 0); PG8_STAGE(PG8_SA(0, 1), a2 + hstepA, voffA, rstepA);
            PG8_WAIT_L(8); PG8_BAR; PG8_WAIT_L(0); PG8_MMA(0, 0, At, B0); PG8_BAR; PG8_SCHED;
            PG8_LDB(B1, 1, 1); PG8_STAGE(PG8_SB(1, 0), b3, voffB, rstepB);
            PG8_BAR; PG8_WAIT_L(0); PG8_MMA(0, 1, At, B1); PG8_BAR;
            PG8_LDA(At, 1, 1); PG8_STAGE(PG8_SA(1, 0), a3, voffA, rstepA);
            PG8_BAR; PG8_WAIT_L(0); PG8_MMA(1, 0, At, B0); PG8_BAR; PG8_SCHED;
            PG8_STAGE(PG8_SB(1, 1), b3 + hstepB, voffB, rstepB);
            PG8_WAIT_V(6); PG8_BAR; PG8_MMA(1, 1, At, B1); PG8_BAR;
            }
        }
        if constexpr (ALIGN_EPI) { if (wr == 0) PG8_BAR; }
        if constexpr (!Epi::AFTER_DRAIN) { E(acc, cur, wr, wc, fr, fq); S.done(cur); }
        if (!has_next) break;
#pragma unroll
        for (int a = 0; a < 2; ++a)
#pragma unroll
            for (int b = 0; b < 2; ++b)
#pragma unroll
                for (int m = 0; m < 4; ++m)
#pragma unroll
                    for (int n = 0; n < 2; ++n) acc[a][b][m][n] = (f32x4){0.f, 0.f, 0.f, 0.f};
        cur = nxt; cA = nA; cB = nB; ++ui;
        if constexpr (ALIGN_EPI) { if (wr == 1) PG8_BAR; }
    }
    PG8_WAIT_V(0);
    if constexpr (!ALIGN_EPI) { if (wr == 0) PG8_BAR; }
    PG8_BAR;
    if constexpr (Epi::AFTER_DRAIN) { E.fused(acc, cur, wr, wc, fr, fq, lds, wid, lane); S.done(cur); }
#undef PG8_SA
#undef PG8_SB
#undef PG8_STAGE
#undef PG8_LDA
#undef PG8_LDB
#undef PG8_MMA
#undef PG8_WAIT_V
#undef PG8_WAIT_L
#undef PG8_BAR
#undef PG8_SCHED
}
}

#ifndef PG8_SP2
#define PG8_SP2 true
#endif
#ifndef PG8_ALIGN
#define PG8_ALIGN true
#endif
#include <hip/hip_bf16.h>
#include <cmath>
namespace attn_body {
using bf16=__hip_bfloat16;
using bf16x8=__attribute__((ext_vector_type(8)))short;
using s16x4=__attribute__((ext_vector_type(4)))short;
using f32x16=__attribute__((ext_vector_type(16)))float;
using u32x4=__attribute__((ext_vector_type(4)))unsigned;
constexpr int D=64;
constexpr int NW=8,QBLK=32,QB=QBLK*NW,KVBLK=64;
__device__ __forceinline__ int crow(int r,int hi){return (r&3)+8*(r>>2)+4*hi;}
#define SBAR() __builtin_amdgcn_sched_barrier(0)
__device__ __forceinline__ void cmask(f32x16&p0,f32x16&p1,int jb,int qrel,int hi){
  const float NEG=-INFINITY; int kb=64*jb+4*hi;
  #pragma unroll
  for(int r=0;r<16;++r){int kv=kb+(r&3)+8*(r>>2); if(kv>qrel)p0[r]=NEG; if(kv+32>qrel)p1[r]=NEG;}
}

constexpr int NSLOT=3, SLOTB=8192;
constexpr int LDS_K=0, LDS_V=NSLOT*SLOTB, LDS_WS=2*NSLOT*SLOTB, LDS_OST=LDS_WS+NW*64*4, LDS_BYTES=LDS_OST+NW*4096;
constexpr float C2=0.125f*1.4426950408889634f;
__device__ __forceinline__ void glds16(const void*gsrc,unsigned lds_dst){unsigned keep;
  asm volatile("s_mov_b32 %0, m0\n\ts_mov_b32 m0, %2\n\ts_nop 0\n\tglobal_load_lds_dwordx4 %1, off\n\ts_mov_b32 m0, %0":"=&s"(keep):"v"(gsrc),"s"(lds_dst):"memory");}
__device__ __forceinline__ float max3f(float a,float b,float c){float r;asm("v_max3_f32 %0, %1, %2, %3":"=v"(r):"v"(a),"v"(b),"v"(c));return r;}
__device__ __forceinline__ float max2f(float a,float b){float r;asm("v_max_f32_e32 %0, %1, %2":"=v"(r):"v"(a),"v"(b));return r;}
__device__ __forceinline__ float fadd_s(float a,float b){float r;asm("v_add_f32_e32 %0, %1, %2":"=v"(r):"v"(a),"v"(b));return r;}
__device__ __forceinline__ float fsub_s(float a,float b){float r;asm("v_sub_f32_e32 %0, %1, %2":"=v"(r):"v"(a),"v"(b));return r;}
typedef float f32x2_t __attribute__((ext_vector_type(2))); typedef __bf16 bf16x2_t __attribute__((ext_vector_type(2)));
__device__ __forceinline__ unsigned cvtpk_s(float lo,float hi){f32x2_t v={lo,hi};bf16x2_t b=__builtin_convertvector(v,bf16x2_t);return __builtin_bit_cast(unsigned,b);}
#define WAIT_BAR(N) asm volatile("s_waitcnt vmcnt(" #N ") lgkmcnt(0)\n\ts_barrier":::"memory")

__device__ __forceinline__ void qkt(f32x16&p0,f32x16&p1,const char*Kslot,const bf16x8*qr,const f32x16&negm,int r32,int hi){
  const char*kb=Kslot+hi*1024+r32*16;
  #pragma unroll
  for(int d0=0;d0<4;++d0){
    const bf16x8 b0=*reinterpret_cast<const bf16x8*>(kb+d0*2048);
    const bf16x8 b1=*reinterpret_cast<const bf16x8*>(kb+d0*2048+512);
    if(d0==0){p0=__builtin_amdgcn_mfma_f32_32x32x16_bf16(b0,qr[0],negm,0,0,0);p1=__builtin_amdgcn_mfma_f32_32x32x16_bf16(b1,qr[0],negm,0,0,0);}
    else{p0=__builtin_amdgcn_mfma_f32_32x32x16_bf16(b0,qr[d0],p0,0,0,0);p1=__builtin_amdgcn_mfma_f32_32x32x16_bf16(b1,qr[d0],p1,0,0,0);}}
}
typedef __attribute__((address_space(3))) const char* lds_cptr;
typedef short v4i16_t __attribute__((ext_vector_type(4)));
__device__ __forceinline__ void kload8(bf16x8*kf,lds_cptr kp){
  kf[0]=*(const __attribute__((address_space(3))) bf16x8*)(kp);      kf[1]=*(const __attribute__((address_space(3))) bf16x8*)(kp+512);
  kf[2]=*(const __attribute__((address_space(3))) bf16x8*)(kp+2048); kf[3]=*(const __attribute__((address_space(3))) bf16x8*)(kp+2560);
  kf[4]=*(const __attribute__((address_space(3))) bf16x8*)(kp+4096); kf[5]=*(const __attribute__((address_space(3))) bf16x8*)(kp+4608);
  kf[6]=*(const __attribute__((address_space(3))) bf16x8*)(kp+6144); kf[7]=*(const __attribute__((address_space(3))) bf16x8*)(kp+6656);
}
__device__ __forceinline__ void kload2(bf16x8*kf,lds_cptr kp,int j){ kf[2*j]=*(const __attribute__((address_space(3))) bf16x8*)(kp+j*2048); kf[2*j+1]=*(const __attribute__((address_space(3))) bf16x8*)(kp+j*2048+512); }
__device__ __forceinline__ s16x4 vtr(lds_cptr p){ return __builtin_bit_cast(s16x4,__builtin_amdgcn_ds_read_tr16_b64_v4i16((__attribute__((address_space(3))) v4i16_t*)p)); }
__device__ __forceinline__ float rowmax(const f32x16&p0,const f32x16&p1){
  float a=max3f(p0[0],p0[1],p1[0]),b=max3f(p0[2],p0[3],p1[1]);a=max3f(a,p1[2],p1[3]);
  #pragma unroll
  for(int r=4;r<16;r+=4){a=max3f(a,p0[r],p0[r+1]);b=max3f(b,p0[r+2],p0[r+3]);a=max3f(a,p1[r],p1[r+1]);b=max3f(b,p1[r+2],p1[r+3]);}
  const float m=max2f(a,b);
  auto rr=__builtin_amdgcn_permlane32_swap(__float_as_uint(m),__float_as_uint(m),false,false);
  return max2f(__uint_as_float(rr[0]),__uint_as_float(rr[1]));
}
__device__ __forceinline__ void pv(f32x16*o,int vb,bf16x8 pa0,bf16x8 pa1,bf16x8 pa2,bf16x8 pa3){
  #pragma unroll
  for(int d0=0;d0<2;++d0){s16x4 lo[4],hi[4];
    #pragma unroll
    for(int ks=0;ks<4;++ks){
      asm volatile("ds_read_b64_tr_b16 %0,%1 offset:%c2":"=&v"(lo[ks]):"v"(vb),"i"(d0*4096+ks*1024):"memory");
      asm volatile("ds_read_b64_tr_b16 %0,%1 offset:%c2":"=&v"(hi[ks]):"v"(vb),"i"(d0*4096+ks*1024+512):"memory");}
    asm volatile("s_waitcnt lgkmcnt(0)":::"memory");SBAR();
    #define PK(k) (bf16x8){lo[k][0],lo[k][1],lo[k][2],lo[k][3],hi[k][0],hi[k][1],hi[k][2],hi[k][3]}
    o[d0]=__builtin_amdgcn_mfma_f32_32x32x16_bf16(pa0,PK(0),o[d0],0,0,0);
    o[d0]=__builtin_amdgcn_mfma_f32_32x32x16_bf16(pa1,PK(1),o[d0],0,0,0);
    o[d0]=__builtin_amdgcn_mfma_f32_32x32x16_bf16(pa2,PK(2),o[d0],0,0,0);
    o[d0]=__builtin_amdgcn_mfma_f32_32x32x16_bf16(pa3,PK(3),o[d0],0,0,0);
    #undef PK
  }
}

#ifndef ATTN_STORE16
#define ATTN_STORE16(p,v) (*(u32x4*)(p)=(v))
#endif
template<int THRL,bool STATIC> __device__ __forceinline__ void attn_unit(const bf16*Qu,const int QP,const bf16*__restrict__ Kh,const bf16*__restrict__ Vh,const int KP,const int NT,bf16*Ou,const int OP,char*shm,const float mstat){
  int tid_=threadIdx.x; asm volatile("":"+v"(tid_));
  const int tid=tid_,lane=tid&63,r32=lane&31,hi=lane>>5; const int wid=__builtin_amdgcn_readfirstlane(tid>>6);
  const bf16*Qw=Qu+(long)(wid*QBLK)*QP;
  const unsigned lds0=(unsigned)(uintptr_t)shm;
  float*wsf=(float*)(shm+LDS_WS)+wid*64;
  const bf16*ksrc=Kh+wid*512+lane*8;
  const bf16*vsrc=Vh+wid*512+lane*8; (void)KP;
  const unsigned kdst=lds0+LDS_K+wid*1024, vdst=lds0+LDS_V+wid*1024;
  #define DMA_K(t,slot) glds16(ksrc+(long)(t)*4096,(unsigned)__builtin_amdgcn_readfirstlane(kdst+(slot)))
  #define DMA_V(t,slot) glds16(vsrc+(long)(t)*4096,(unsigned)__builtin_amdgcn_readfirstlane(vdst+(slot)))
  const int vb0=(int)(lds0+LDS_V)+((lane>>4)&1)*32+(lane&3)*8+(4*hi+((lane&15)>>2))*64;
  const char*Kbase=shm+LDS_K; bf16x8 kf[8];
  const lds_cptr shm3=(lds_cptr)shm; const lds_cptr kp0=shm3+LDS_K+hi*1024+r32*16; const lds_cptr vp0=shm3+LDS_V+((lane>>4)&1)*32+(lane&3)*8+(4*hi+((lane&15)>>2))*64;
  DMA_K(0,0);DMA_V(0,0);DMA_K(1,SLOTB);
  bf16x8 qr[4];
  #pragma unroll
  for(int d0=0;d0<4;++d0)qr[d0]=*reinterpret_cast<const bf16x8*>(&Qw[(long)r32*QP+d0*16+hi*8]);
  float mhat=0.f,l_reg=0.f;f32x16 o[2];o[0]=f32x16{};o[1]=f32x16{};f32x16 negm=f32x16{};asm volatile("":"+v"(negm));
  #define CMASK(P0,P1,t) do{}while(0)
  bool resc=false;
  #define START(P0,P1) do{ float rm; if constexpr(STATIC){rm=mstat;}else{rm=rowmax(P0,P1);} resc=false; \
    { const float dl=rm; mhat=fadd_s(mhat,dl); \
      _Pragma("unroll") for(int r=0;r<16;++r){P0[r]=fsub_s(P0[r],dl);P1[r]=fsub_s(P1[r],dl);} \
      _Pragma("unroll") for(int r=0;r<16;++r)negm[r]=-mhat; asm volatile("":"+v"(negm)); } \
    _Pragma("unroll") for(int r=0;r<16;++r)P0[r]=__builtin_amdgcn_exp2f(P0[r]); }while(0)
  #define RESC() do{ if(resc){ asm volatile("s_waitcnt lgkmcnt(0)":::"memory"); \
      _Pragma("unroll") for(int d_=0;d_<2;++d_) _Pragma("unroll") for(int r=0;r<16;++r)o[d_][r]*=wsf[crow(r,hi)]; } }while(0)
  f32x16 pA0,pA1,pB0,pB1;
  int sl_prev=0,sl_cur=0,sl_next=SLOTB;
  #define ROT() do{sl_prev=sl_cur;sl_cur=sl_next;sl_next=(sl_next==(NSLOT-1)*SLOTB)?0:sl_next+SLOTB;}while(0)
  DMA_K(2,2*SLOTB);
  WAIT_BAR(3);
  qkt(pA0,pA1,Kbase,qr,negm,r32,hi);asm volatile("s_nop 15\n\ts_nop 7":"+v"(pA0),"+v"(pA1));CMASK(pA0,pA1,0);
  START(pA0,pA1);
  _Pragma("unroll") for(int r=0;r<16;++r)pA1[r]=__builtin_amdgcn_exp2f(pA1[r]);
  WAIT_BAR(0);
  DMA_K(3,0);DMA_V(1,SLOTB);
  ROT();
  kload8(kf,kp0+sl_cur);
  WAIT_BAR(2);
  s16x4 vlo[8],vhi[8]; u32x4 pw0,pw1,pw2,pw3;
  #define PKW(P,B) cvtpk_s(P[B],P[B+1])
  #define PAF(k) __builtin_bit_cast(bf16x8,pw##k)
  #define VFR(i) (bf16x8){vlo[i][0],vlo[i][1],vlo[i][2],vlo[i][3],vhi[i][0],vhi[i][1],vhi[i][2],vhi[i][3]}
  #define PIN(x) asm volatile("":"+v"(x))
  #define MX3(a,b,c) __builtin_fmaxf(__builtin_fmaxf((a),(b)),(c))
  #define GAPA(MF,A0,A1,A2,A3,W0,W1,PW) do{ MF; sacc+=A0; sacc+=A1; sacc+=A2; sacc+=A3; PIN(sacc); W0; W1; PIN(PW); SBAR(); }while(0)
  #define EX(v) __builtin_amdgcn_exp2f(v)
  #define GAPB(MF,X,B) do{ MF; X[B]=EX(X[B]); X[B+1]=EX(X[B+1]); X[B+2]=EX(X[B+2]); X[B+3]=EX(X[B+3]); PIN(X); SBAR(); }while(0)
  #define VRD(i) do{ vlo[i]=vtr(vp_+(((i)>>2)*4096+((i)&3)*1024)); vhi[i]=vtr(vp_+(((i)>>2)*4096+((i)&3)*1024+512)); }while(0)
  #define KRD(G,j) do{ if(G){ kload2(kf,kp0+sl_next,j); SBAR(); } }while(0)
  #define STEP(C0,C1,P0,P1,t,GK,GV,GL) do{ SBAR(); \
    const lds_cptr vp_=vp0+sl_prev; \
    VRD(0); SBAR(); float sacc=(P0[0]+P0[1]); \
    GAPA(C0=__builtin_amdgcn_mfma_f32_32x32x16_bf16(kf[0],qr[0],negm,0,0,0), P0[2],P0[3],P0[4],P0[5],     pw0[0]=PKW(P0,0), pw0[1]=PKW(P0,2), pw0); \
    VRD(4); SBAR(); GAPA(C1=__builtin_amdgcn_mfma_f32_32x32x16_bf16(kf[1],qr[0],negm,0,0,0), P0[6],P0[7],P0[8],P0[9],     pw0[2]=PKW(P0,4), pw0[3]=PKW(P0,6), pw0); \
    VRD(1); SBAR(); GAPA(C0=__builtin_amdgcn_mfma_f32_32x32x16_bf16(kf[2],qr[1],C0,0,0,0),   P0[10],P0[11],P0[12],P0[13], pw1[0]=PKW(P0,8), pw1[1]=PKW(P0,10), pw1); \
    VRD(5); SBAR(); GAPA(C1=__builtin_amdgcn_mfma_f32_32x32x16_bf16(kf[3],qr[1],C1,0,0,0),   P0[14],P0[15],P1[0],P1[1],   pw1[2]=PKW(P0,12),pw1[3]=PKW(P0,14), pw1); \
    VRD(2); SBAR(); GAPA(C0=__builtin_amdgcn_mfma_f32_32x32x16_bf16(kf[4],qr[2],C0,0,0,0),   P1[2],P1[3],P1[4],P1[5],     pw2[0]=PKW(P1,0), pw2[1]=PKW(P1,2), pw2); \
    VRD(6); SBAR(); GAPA(C1=__builtin_amdgcn_mfma_f32_32x32x16_bf16(kf[5],qr[2],C1,0,0,0),   P1[6],P1[7],P1[8],P1[9],     pw2[2]=PKW(P1,4), pw2[3]=PKW(P1,6), pw2); \
    VRD(3); SBAR(); GAPA(C0=__builtin_amdgcn_mfma_f32_32x32x16_bf16(kf[6],qr[3],C0,0,0,0),   P1[10],P1[11],P1[12],P1[13], pw3[0]=PKW(P1,8), pw3[1]=PKW(P1,10), pw3); \
    VRD(7); SBAR(); GAPA(C1=__builtin_amdgcn_mfma_f32_32x32x16_bf16(kf[7],qr[3],C1,0,0,0),   P1[14],P1[15],0.f,0.f,       pw3[2]=PKW(P1,12),pw3[3]=PKW(P1,14), pw3); \
    l_reg+=sacc; \
    if(GK){DMA_K((t)+3,sl_cur);} if(GV){DMA_V((t)+1,sl_next);} \
    CMASK(C0,C1,t); \
    if constexpr(!STATIC){ float a=MX3(C0[0],C0[1],C1[0]),b=MX3(C0[2],C0[3],C1[1]); a=MX3(a,C1[2],C1[3]); \
      _Pragma("unroll") for(int r=4;r<16;r+=4){a=MX3(a,C0[r],C0[r+1]);b=MX3(b,C0[r+2],C0[r+3]);a=MX3(a,C1[r],C1[r+1]);b=MX3(b,C1[r+2],C1[r+3]);} \
      float rm=__builtin_fmaxf(a,b); { auto rr=__builtin_amdgcn_permlane32_swap(__float_as_uint(rm),__float_as_uint(rm),false,false); rm=__builtin_fmaxf(__uint_as_float(rr[0]),__uint_as_float(rr[1])); } \
      resc=false; \
      if(__builtin_expect(__any(rm>(float)THRL),0)){ const float dl=__builtin_fmaxf(rm,0.f); mhat+=dl; \
        _Pragma("unroll") for(int r=0;r<16;++r){C0[r]-=dl;C1[r]-=dl;} \
        _Pragma("unroll") for(int r=0;r<16;++r)negm[r]=-mhat; asm volatile("":"+v"(negm)); \
        const float f=__builtin_amdgcn_exp2f(-dl); l_reg*=f; if(hi==0)wsf[r32]=f; resc=true; } } \
    SBAR(); \
    GAPB(o[0]=__builtin_amdgcn_mfma_f32_32x32x16_bf16(PAF(0),VFR(0),o[0],0,0,0), C0,0); \
    GAPB(o[1]=__builtin_amdgcn_mfma_f32_32x32x16_bf16(PAF(0),VFR(4),o[1],0,0,0), C0,4); \
    KRD(GL,0); GAPB(o[0]=__builtin_amdgcn_mfma_f32_32x32x16_bf16(PAF(1),VFR(1),o[0],0,0,0), C0,8); \
    KRD(GL,1); GAPB(o[1]=__builtin_amdgcn_mfma_f32_32x32x16_bf16(PAF(1),VFR(5),o[1],0,0,0), C0,12); \
    KRD(GL,2); GAPB(o[0]=__builtin_amdgcn_mfma_f32_32x32x16_bf16(PAF(2),VFR(2),o[0],0,0,0), C1,0); \
    KRD(GL,3); GAPB(o[1]=__builtin_amdgcn_mfma_f32_32x32x16_bf16(PAF(2),VFR(6),o[1],0,0,0), C1,4); \
    GAPB(o[0]=__builtin_amdgcn_mfma_f32_32x32x16_bf16(PAF(3),VFR(3),o[0],0,0,0), C1,8); \
    GAPB(o[1]=__builtin_amdgcn_mfma_f32_32x32x16_bf16(PAF(3),VFR(7),o[1],0,0,0), C1,12); \
    }while(0)
  int t=1;
  #undef CMASK
  #define CMASK(P0,P1,t) do{}while(0)
  for(;t+5<NT;t+=2){
    STEP(pB0,pB1,pA0,pA1,t,true,true,true);     WAIT_BAR(2); RESC(); ROT();
    STEP(pA0,pA1,pB0,pB1,t+1,true,true,true);   WAIT_BAR(2); RESC(); ROT();
  }
  #undef CMASK
  #define CMASK(P0,P1,t) do{}while(0)
  #define ENDW(tt) do{ if((tt)+3<NT){WAIT_BAR(2);} else if((tt)+2<NT){WAIT_BAR(1);} else {WAIT_BAR(0);} }while(0)
  for(;t+1<NT;t+=2){
    STEP(pB0,pB1,pA0,pA1,t,(t+3<NT),(t+1<NT),(t+1<NT));       ENDW(t);   RESC(); ROT();
    STEP(pA0,pA1,pB0,pB1,t+1,(t+4<NT),(t+2<NT),(t+2<NT));     ENDW(t+1); RESC(); ROT();
  }
  STEP(pB0,pB1,pA0,pA1,NT-1,false,false,false); RESC();
  { float sacc=pB0[0]+pB0[1]; _Pragma("unroll") for(int r=2;r<16;++r)sacc+=pB0[r]; _Pragma("unroll") for(int r=0;r<16;++r)sacc+=pB1[r]; l_reg+=sacc;
    pw0=(u32x4){PKW(pB0,0),PKW(pB0,2),PKW(pB0,4),PKW(pB0,6)};pw1=(u32x4){PKW(pB0,8),PKW(pB0,10),PKW(pB0,12),PKW(pB0,14)};pw2=(u32x4){PKW(pB1,0),PKW(pB1,2),PKW(pB1,4),PKW(pB1,6)};pw3=(u32x4){PKW(pB1,8),PKW(pB1,10),PKW(pB1,12),PKW(pB1,14)};
    SBAR(); pv(o,vb0+sl_cur,PAF(0),PAF(1),PAF(2),PAF(3)); }
  #undef PKW
  #undef PAF
  #undef VFR
  #undef PIN
  #undef MX3
  #undef GAPA
  #undef GAPB
  #undef EX
  #undef VRD
  #undef KRD
  #undef STEP
  #undef ENDW
  {auto rr=__builtin_amdgcn_permlane32_swap(__float_as_uint(l_reg),__float_as_uint(l_reg),false,false);l_reg=__uint_as_float(rr[0])+__uint_as_float(rr[1]);}
  if(hi==0)wsf[32+r32]=l_reg;asm volatile("s_waitcnt lgkmcnt(0)":::"memory");
  float rli[16];
  #pragma unroll
  for(int r=0;r<16;++r)rli[r]=__builtin_amdgcn_rcpf(wsf[32+crow(r,hi)]);
  bf16*Ow=Ou+(long)(wid*QBLK)*OP;
  { bf16*stg=(bf16*)(shm+LDS_OST)+wid*2048;
    #pragma unroll
    for(int r=0;r<16;++r){const int orow=crow(r,hi);
      #pragma unroll
      for(int d0=0;d0<2;++d0)stg[orow*64+d0*32+r32]=__float2bfloat16(o[d0][r]*rli[r]);}
    asm volatile("s_waitcnt lgkmcnt(0)":::"memory");
    #pragma unroll
    for(int i=0;i<4;++i){const int row=i*8+(lane>>3),ch=lane&7; const u32x4 v=*(const u32x4*)(stg+row*64+ch*8); ATTN_STORE16(Ow+(long)row*OP+ch*8,v);} }
  asm volatile("s_waitcnt lgkmcnt(0)\n\ts_barrier":::"memory");
  #undef DMA_K
  #undef DMA_V
  #undef CMASK
  #undef START
  #undef RESC
  #undef ROT
}
constexpr int ATTN_LDS_BYTES=LDS_BYTES;
#undef SBAR
#undef WAIT_BAR
}
#ifndef REP_P0
#define REP_P0 1
#endif
#ifndef REP_PA
#define REP_PA 1
#endif
#ifndef REP_PB
#define REP_PB 1
#endif
#ifndef REP_PC
#define REP_PC 1
#endif
#ifndef REP_PE
#define REP_PE 1
#endif
#ifndef REP_PF
#define REP_PF 1
#endif
#ifndef REP_PG
#define REP_PG 1
#endif

#include <hip/hip_cooperative_groups.h>
namespace cg = cooperative_groups;
#define LAS __attribute__((address_space(3)))
#define GAS_ __attribute__((address_space(1)))
typedef unsigned short bf16;
typedef unsigned v4u __attribute__((ext_vector_type(4)));
typedef unsigned v2u __attribute__((ext_vector_type(2)));
typedef float f32x4 __attribute__((ext_vector_type(4)));
typedef float f32x2 __attribute__((ext_vector_type(2)));
typedef short bf16x8 __attribute__((ext_vector_type(8)));

constexpr int NWAVES = 8, NTHR = 512;
constexpr int DMOD = 1024, NLAT = 16384, NCTXR = 512, MROWS = 16896, SEQL = 8192, CTXL = 256, NLAYER = 4;
constexpr int DIN = 2048, DFF = 2816, DUP = 5632, KVROWS = 8448, NMOD = 6;
constexpr float EPS = 1e-6f;
constexpr float QSCALE = 0.125f * 1.4426950408889634f;

constexpr size_t MiB = 1u << 20;
constexpr size_t WS_MODV = 0;
constexpr size_t WS_BAR = 384 * 1024;
constexpr size_t WS_PTRS = 448 * 1024;
constexpr size_t WS_ROPE = 512 * 1024;
constexpr size_t WS_XSC = 1 * MiB;
constexpr size_t WS_W0 = 4 * MiB, WS_W1 = 258 * MiB, WS_WSTRIDE = 23592960;
constexpr size_t WO_WIN = 0, WO_WOUT = 4 * MiB, WO_WUP = 6 * MiB, WO_WDN = 17 * MiB;
constexpr size_t WS_CNT = 400 * 1024;
constexpr size_t WS_ACT = 28 * MiB;
constexpr size_t WS_Q = 120 * MiB;
constexpr size_t WS_K = WS_Q + (size_t)MROWS * 512 * 2;
constexpr size_t WS_V = WS_K + (size_t)MROWS * 128 * 2;
constexpr size_t WS_U = WS_V + (size_t)MROWS * 128 * 2;
constexpr size_t WS_VN = WS_U + (size_t)MROWS * 256 * 2;
constexpr size_t WS_CB = WS_VN + (size_t)MROWS * 256 * 2;
constexpr size_t WS_CCH = WS_CB + (size_t)MROWS * 256 * 2;
constexpr size_t WS_MIX = WS_CCH + (size_t)MROWS * 256 * 2;
constexpr size_t WS_HALO = 211 * MiB;
constexpr size_t WS_H = 224 * MiB;
constexpr size_t WS_XB = WS_W1 + WS_WSTRIDE;
constexpr size_t WS_END = WS_XB + (size_t)NLAT * 1024 * 2;
static_assert(WS_MIX + (size_t)MROWS * 1024 * 2 <= WS_HALO && WS_HALO + (size_t)(MROWS / 128) * 4 * DUP * 4 <= WS_H && WS_ACT + (size_t)MROWS * DFF * 2 <= WS_Q && WS_W0 + WS_WSTRIDE <= WS_ACT && WO_WDN + (size_t)1024 * DFF * 2 <= WS_WSTRIDE && WS_H + (size_t)MROWS * 1024 * 2 <= WS_W1, "ws map");

constexpr int RING_BYTES = 131072, LDS_BYTES = 147456;

__device__ __forceinline__ unsigned pk2(float lo, float hi) { return pg8::cvt_pk_bf16(lo, hi); }
__device__ __forceinline__ float bf_lo(unsigned w) { return __uint_as_float(w << 16); }
__device__ __forceinline__ float bf_hi(unsigned w) { return __uint_as_float(w & 0xffff0000u); }
__device__ __forceinline__ float sigmoid_f(float x) { return __builtin_amdgcn_rcpf(1.f + __builtin_amdgcn_exp2f(-1.4426950408889634f * x)); }
__device__ __forceinline__ float silu_f(float x) { return x * sigmoid_f(x); }
__device__ __forceinline__ float gelu_t(float x) { const float z = 0.7978845608028654f * (x + 0.044715f * x * x * x); return x * sigmoid_f(2.f * z); }
__device__ __forceinline__ float wave_sum(float v) {
#pragma unroll
    for (int o = 1; o < 64; o <<= 1) v += __shfl_xor(v, o);
    return v;
}

namespace pg8 {
typedef unsigned u32x2 __attribute__((ext_vector_type(2)));
struct EpiResid {
    static constexpr bool PERM = true, AFTER_DRAIN = false, ROWPERM = false;
    const bf16_t* base_lat; bf16_t* out_lat; const float* modv; int gi;
    __device__ __forceinline__ void operator()(const f32x4 (&acc)[2][2][4][2], const Unit& u, int wr, int wc, int fr, int fq) const {
        const int s = u.pm < 32 ? 0 : 1;
        const float* g = modv + (size_t)(s * 6 + gi) * 1024;
        const bf16_t* bp = base_lat + (size_t)u.pm * 256 * 1024; bf16_t* op = out_lat + (size_t)u.pm * 256 * 1024;
        const int col0 = u.pn * 256 + wc * 32 + 8 * fq;
        f32x4 gv[2][2];
#pragma unroll
        for (int bj = 0; bj < 2; ++bj)
#pragma unroll
            for (int n = 0; n < 2; ++n) gv[bj][n] = *(const f32x4*)(g + col0 + bj * 128 + 4 * n);
#pragma unroll
        for (int ai = 0; ai < 2; ++ai) {
        u32x4 b[4][2];
#pragma unroll
            for (int m = 0; m < 4; ++m) { const size_t off = (size_t)(ai * 128 + wr * 64 + m * 16 + fr) * 1024 + col0;
#pragma unroll
                for (int bj = 0; bj < 2; ++bj) b[m][bj] = *(const u32x4*)(bp + off + bj * 128); }
        asm volatile("" ::: "memory");
#pragma unroll
            for (int m = 0; m < 4; ++m) { const size_t off = (size_t)(ai * 128 + wr * 64 + m * 16 + fr) * 1024 + col0;
#pragma unroll
                for (int bj = 0; bj < 2; ++bj) { const u32x4 w = b[m][bj];
                    const f32x4 x0 = (f32x4){__uint_as_float(w.x << 16), __uint_as_float(w.x & 0xffff0000u), __uint_as_float(w.y << 16), __uint_as_float(w.y & 0xffff0000u)} + gv[bj][0] * acc[ai][bj][m][0];
                    const f32x4 x1 = (f32x4){__uint_as_float(w.z << 16), __uint_as_float(w.z & 0xffff0000u), __uint_as_float(w.w << 16), __uint_as_float(w.w & 0xffff0000u)} + gv[bj][1] * acc[ai][bj][m][1];
                    u32x4 o; o.x = cvt_pk_bf16(x0[0], x0[1]); o.y = cvt_pk_bf16(x0[2], x0[3]); o.z = cvt_pk_bf16(x1[0], x1[1]); o.w = cvt_pk_bf16(x1[2], x1[3]);
                    *(u32x4*)(op + off + bj * 128) = o; } }
        asm volatile("" ::: "memory");
        }
    }
};

struct EpiProj {
    static constexpr bool PERM = true, AFTER_DRAIN = false, ROWPERM = false;
    bf16_t *Q, *KB, *VB, *U, *VN, *CB, *CCH;
    const float *qg, *kg; const f32x2* rope;
    __device__ __forceinline__ static void st8(bf16_t* p, const float (&o)[8]) {
        u32x4 w; w.x = cvt_pk_bf16(o[0], o[1]); w.y = cvt_pk_bf16(o[2], o[3]); w.z = cvt_pk_bf16(o[4], o[5]); w.w = cvt_pk_bf16(o[6], o[7]); *(u32x4*)p = w;
    }
    __device__ __forceinline__ void operator()(const f32x4 (&acc)[2][2][4][2], const Unit& u, int wr, int wc, int fr, int fq) const {
        const int pn = u.pn, pm = u.pm;
        const bool isctx = pm >= 64;
        const int kvb = isctx ? (pm - 64) : (pm >> 5), kvr0 = isctx ? 0 : 256 + (pm & 31) * 256;
        const int dof = 8 * fq;
        float gq[2][8];
        const bool qk = (pn == 2 || pn == 3 || (pn == 4 && wc < 2));
        if (qk) { const float* gp = (pn == 4) ? kg : qg;
#pragma unroll
            for (int bj = 0; bj < 2; ++bj)
#pragma unroll
                for (int k = 0; k < 8; ++k) gq[bj][k] = gp[32 * bj + dof + k]; }
#pragma unroll
        for (int ai = 0; ai < 2; ++ai)
#pragma unroll
            for (int m = 0; m < 4; ++m) {
                const int rl = ai * 128 + wr * 64 + m * 16 + fr; const int gm = pm * 256 + rl;
                float v[2][8];
#pragma unroll
                for (int bj = 0; bj < 2; ++bj)
#pragma unroll
                    for (int n = 0; n < 2; ++n)
#pragma unroll
                        for (int i = 0; i < 4; ++i) v[bj][4 * n + i] = acc[ai][bj][m][n][i];
                if (pn == 0) {
#pragma unroll
                    for (int bj = 0; bj < 2; ++bj) { float o[8];
#pragma unroll
                        for (int k = 0; k < 8; ++k) o[k] = gelu_t(v[bj][k]);
                        st8(U + (size_t)gm * 256 + 64 * wc + 32 * bj + dof, o); }
                } else if (pn == 1) {
                    float s = 0.f;
#pragma unroll
                    for (int bj = 0; bj < 2; ++bj)
#pragma unroll
                        for (int k = 0; k < 8; ++k) { v[bj][k] = gelu_t(v[bj][k]); s += v[bj][k]; }
                    s += __shfl_xor(s, 16); s += __shfl_xor(s, 32);
                    const float mean = s * (1.f / 64.f); float q = 0.f;
#pragma unroll
                    for (int bj = 0; bj < 2; ++bj)
#pragma unroll
                        for (int k = 0; k < 8; ++k) { v[bj][k] -= mean; q += v[bj][k] * v[bj][k]; }
                    q += __shfl_xor(q, 16); q += __shfl_xor(q, 32);
                    const float rstd = rsqrtf(q * (1.f / 64.f) + EPS);
#pragma unroll
                    for (int bj = 0; bj < 2; ++bj) { float o[8];
#pragma unroll
                        for (int k = 0; k < 8; ++k) o[k] = v[bj][k] * rstd;
                        st8(VN + (size_t)gm * 256 + 64 * wc + 32 * bj + dof, o); }
                } else if (qk) {
                    float ss = 0.f;
#pragma unroll
                    for (int bj = 0; bj < 2; ++bj)
#pragma unroll
                        for (int k = 0; k < 8; ++k) ss += v[bj][k] * v[bj][k];
                    ss += __shfl_xor(ss, 16); ss += __shfl_xor(ss, 32);
                    const float r = rsqrtf(ss * (1.f / 64.f) + EPS);
                    const int t = gm & (SEQL - 1);
                    const float osc = (pn == 4) ? 1.f : QSCALE;
#pragma unroll
                    for (int bj = 0; bj < 2; ++bj) { float o[8];
                        const int pos = (bj == 0) ? (t >> 6) : (t & 63);
                        const f32x2* rp = rope + pos * 16 + 8 * (fq & 1);
                        f32x4 cs4[4];
                        if (!isctx) {
#pragma unroll
                            for (int k = 0; k < 4; ++k) cs4[k] = ((const f32x4*)rp)[k];
                        }
#pragma unroll
                        for (int k = 0; k < 8; ++k) {
                            float y = v[bj][k] * r * gq[bj][k];
                            if (!isctx) { const float pr = __shfl_xor(y, 32); const float cx = cs4[k >> 1][2 * (k & 1)], sx = cs4[k >> 1][2 * (k & 1) + 1]; y = (fq < 2) ? (y * cx - pr * sx) : (y * cx + pr * sx); }
                            o[k] = y * osc; }
                        if (pn == 4) { const int kvr = kvr0 + rl; st8(KB + ((((size_t)(kvb * 2 + wc) * (KVROWS / 64) + (kvr >> 6)) * 8 + (4 * bj + fq)) * 64 + (kvr & 63)) * 8, o); }
                        else st8(Q + (size_t)gm * 512 + 64 * (4 * (pn - 2) + wc) + 32 * bj + dof, o); }
                } else if (pn == 4) {
#pragma unroll
                    for (int bj = 0; bj < 2; ++bj) { const int kvr = kvr0 + rl; st8(VB + ((((size_t)(kvb * 2 + wc - 2) * (KVROWS / 64) + (kvr >> 6)) * 8 + (4 * bj + ((kvr >> 4) & 3))) * 16 + (kvr & 15)) * 32 + dof, v[bj]); }
                } else if (pn == 5) {
#pragma unroll
                    for (int bj = 0; bj < 2; ++bj) st8(CB + (size_t)gm * 256 + 64 * wc + 32 * bj + dof, v[bj]);
                } else {
                    float o[8];
#pragma unroll
                    for (int k = 0; k < 8; ++k) o[k] = v[0][k] * v[1][k];
                    st8(CCH + (size_t)gm * 256 + 128 * (pn - 6) + 32 * wc + dof, o);
                }
            }
    }
};
struct EpiUpConv {
    static constexpr bool PERM = true, AFTER_DRAIN = false, ROWPERM = true;
    bf16_t* ACT; float* HALO; const float* cw;
    __device__ __forceinline__ void operator()(const f32x4 (&acc)[2][2][4][2], const Unit& u, int wr, int wc, int fr, int fq) const {
        const int rbase = u.pm * 256 + 128 * wr + 8 * fr, seg = u.pm * 2 + wr;
        const int ch0 = 128 * u.pn + 32 * wc + 8 * fq;
        unsigned pk[8][4];
#pragma unroll
        for (int n = 0; n < 2; ++n) {
            const int ch = ch0 + 4 * n;
            const f32x4 wa0 = *(const f32x4*)(cw + ch), wa1 = *(const f32x4*)(cw + DUP + ch), wa2 = *(const f32x4*)(cw + 2 * DUP + ch);
            const f32x4 wg0 = *(const f32x4*)(cw + DFF + ch), wg1 = *(const f32x4*)(cw + DUP + DFF + ch), wg2 = *(const f32x4*)(cw + 2 * DUP + DFF + ch);
            float act[8][4];
#pragma unroll
            for (int i = 0; i < 4; ++i) {
                float a[10], g[10];
#pragma unroll
                for (int ai = 0; ai < 2; ++ai)
#pragma unroll
                    for (int m = 0; m < 4; ++m) { a[1 + 4 * ai + m] = acc[ai][0][m][n][i]; g[1 + 4 * ai + m] = acc[ai][1][m][n][i]; }
                const float au = __shfl_up(a[8], 1, 16), ad = __shfl_down(a[1], 1, 16), gu = __shfl_up(g[8], 1, 16), gd = __shfl_down(g[1], 1, 16);
                a[0] = fr == 0 ? 0.f : au; a[9] = fr == 15 ? 0.f : ad; g[0] = fr == 0 ? 0.f : gu; g[9] = fr == 15 ? 0.f : gd;
#pragma unroll
                for (int j = 0; j < 8; ++j) {
                    const float ca = wa0[i] * a[j] + wa1[i] * a[j + 1] + wa2[i] * a[j + 2];
                    const float cg = wg0[i] * g[j] + wg1[i] * g[j + 1] + wg2[i] * g[j + 2];
                    act[j][i] = silu_f(cg) * ca;
                }
            }
#pragma unroll
            for (int j = 0; j < 8; ++j) { pk[j][2 * n] = cvt_pk_bf16(act[j][0], act[j][1]); pk[j][2 * n + 1] = cvt_pk_bf16(act[j][2], act[j][3]); }
        }
#pragma unroll
        for (int j = 0; j < 8; ++j) { u32x4 w; w.x = pk[j][0]; w.y = pk[j][1]; w.z = pk[j][2]; w.w = pk[j][3]; *(u32x4*)(ACT + (size_t)(rbase + j) * DFF + ch0) = w; }
        if (fr == 0 || fr == 15) {
            float* hp = HALO + (size_t)(seg * 4 + (fr == 0 ? 0 : 2)) * DUP + ch0;
#pragma unroll
            for (int bj = 0; bj < 2; ++bj)
#pragma unroll
                for (int n = 0; n < 2; ++n) {
                    const f32x4 r0 = fr == 0 ? acc[0][bj][0][n] : acc[1][bj][2][n], r1 = fr == 0 ? acc[0][bj][1][n] : acc[1][bj][3][n];
                    *(f32x4*)(hp + bj * DFF + 4 * n) = r0; *(f32x4*)(hp + DUP + bj * DFF + 4 * n) = r1;
                }
        }
    }
};
}

__device__ __forceinline__ int win_map(int L) {
    if (L < 1536) { const int T = L >> 8, l = L & 255, head = l >> 6, d = l & 63; return 256 * T + 128 * (d >> 5) + 32 * head; }
    if (L < 1792) { const int ch = L - 1536; return 256 * (6 + (ch >> 7)) + (ch & 127); }
    const int ch = L - 1792; return 256 * (6 + (ch >> 7)) + 128 + (ch & 127);
}
__device__ __forceinline__ int up_map(int L) { if (L < DFF) return 256 * (L >> 7) + (L & 127); const int ch = L - DFF; return 256 * (ch >> 7) + 128 + (ch & 127); }
template <int MAP> __device__ __forceinline__ void transpose_item(const float* W, int K, int N, bf16* WT, LAS float* scr, int item, int lane) {
    const int nblk = N / 32, kb = item / nblk, nb = item % nblk, k0 = 64 * kb, n0 = 32 * nb;
    const int r0 = MAP == 1 ? win_map(n0) : (MAP == 2 ? up_map(n0) : n0);
    float tmp[32];
#pragma unroll
    for (int i = 0; i < 32; ++i) tmp[i] = W[(size_t)(k0 + 2 * i + (lane >> 5)) * N + n0 + (lane & 31)];
#pragma unroll
    for (int i = 0; i < 32; ++i) scr[(2 * i + (lane >> 5)) * 33 + (lane & 31)] = tmp[i];
    asm volatile("s_waitcnt lgkmcnt(0)" ::: "memory");
    const int c = lane & 7;
#pragma unroll
    for (int j = 0; j < 4; ++j) { const int n = (lane >> 3) + 8 * j; const LAS float* s = scr + (8 * c) * 33 + n;
        v4u o; o.x = pk2(s[0 * 33], s[1 * 33]); o.y = pk2(s[2 * 33], s[3 * 33]); o.z = pk2(s[4 * 33], s[5 * 33]); o.w = pk2(s[6 * 33], s[7 * 33]);
        *(v4u*)(WT + pg8::wt_off(r0 + n, k0 + 8 * c, K / 64, MAP != 0)) = o; }
    asm volatile("s_waitcnt lgkmcnt(0)" ::: "memory");
}
constexpr int CI_IN = 16 * (DIN / 32), CI_OUT = 16 * 32, CI_UP = 16 * (DUP / 32), CI_DN = (DFF / 64) * 32, CONV_ITEMS = CI_IN + CI_OUT + CI_UP + CI_DN;
__device__ __forceinline__ void convert_item(int it, int l, const float* w_in, const float* w_out, const float* ffn_up, const float* ffn_down, unsigned char* ws, LAS float* scr, int lane) {
    unsigned char* wl_ = ws + ((l & 1) ? WS_W1 : WS_W0); int r = it;
    if (r < CI_IN) { transpose_item<1>(w_in + (size_t)l * 1024 * DIN, 1024, DIN, (bf16*)(wl_ + WO_WIN), scr, r, lane); return; } r -= CI_IN;
    if (r < CI_OUT) { transpose_item<3>(w_out + (size_t)l * 1024 * 1024, 1024, 1024, (bf16*)(wl_ + WO_WOUT), scr, r, lane); return; } r -= CI_OUT;
    if (r < CI_UP) { transpose_item<2>(ffn_up + (size_t)l * 1024 * DUP, 1024, DUP, (bf16*)(wl_ + WO_WUP), scr, r, lane); return; } r -= CI_UP;
    transpose_item<3>(ffn_down + (size_t)l * DFF * 1024, DFF, 1024, (bf16*)(wl_ + WO_WDN), scr, r, lane);
}
__device__ __forceinline__ void norm_load(const float* xrow, int lane, f32x4 (&v)[4]) {
    const f32x4* xr = (const f32x4*)xrow + lane;
#pragma unroll
    for (int j = 0; j < 4; ++j) v[j] = xr[64 * j];
}
__device__ __forceinline__ void norm_load_bf(const bf16* xrow, int lane, f32x4 (&v)[4]) {
    const v2u* xr = (const v2u*)xrow + lane;
#pragma unroll
    for (int j = 0; j < 4; ++j) { const v2u w = xr[64 * j]; v[j] = (f32x4){bf_lo(w.x), bf_hi(w.x), bf_lo(w.y), bf_hi(w.y)}; }
}
__device__ __forceinline__ void norm_finish(const f32x4 (&v)[4], const float* g, const float* sh, const float* sc, bf16* orow, int lane) {
    float s = 0.f;
#pragma unroll
    for (int j = 0; j < 4; ++j) s += (v[j].x * v[j].x + v[j].y * v[j].y) + (v[j].z * v[j].z + v[j].w * v[j].w);
    const float r = rsqrtf(wave_sum(s) * (1.f / 1024.f) + EPS);
    v2u* o8 = (v2u*)orow + lane;
#pragma unroll
    for (int j = 0; j < 4; ++j) {
        const f32x4 gg = ((const f32x4*)g)[lane + 64 * j], ss = ((const f32x4*)sh)[lane + 64 * j], cc = ((const f32x4*)sc)[lane + 64 * j];
        const f32x4 y = (v[j] * r * gg) * (cc + 1.f) + ss;
        v2u w; w.x = pk2(y.x, y.y); w.y = pk2(y.z, y.w); o8[64 * j] = w; }
}
#define NORM_ROWS(XLAT, XCTX, GAIN, MODP, SHI, SCI) do { \
    for (int m = gw; m < MROWS; m += 2 * NGW) { const int m2 = m + NGW; const bool has2 = m2 < MROWS; const int mb = has2 ? m2 : m; \
        f32x4 va[4], vb[4]; \
        if (m < NLAT) norm_load_bf((XLAT) + (size_t)m * 1024, lane, va); else norm_load((XCTX) + (size_t)(m - NLAT) * 1024, lane, va); \
        if (mb < NLAT) norm_load_bf((XLAT) + (size_t)mb * 1024, lane, vb); else norm_load((XCTX) + (size_t)(mb - NLAT) * 1024, lane, vb); \
        { const int s_ = m < SEQL ? 0 : (m < NLAT ? 1 : 2); norm_finish(va, (GAIN), (MODP) + (size_t)(s_ * 6 + (SHI)) * 1024, (MODP) + (size_t)(s_ * 6 + (SCI)) * 1024, H + (size_t)m * 1024, lane); } \
        if (has2) { const int s_ = mb < SEQL ? 0 : (mb < NLAT ? 1 : 2); norm_finish(vb, (GAIN), (MODP) + (size_t)(s_ * 6 + (SHI)) * 1024, (MODP) + (size_t)(s_ * 6 + (SCI)) * 1024, H + (size_t)mb * 1024, lane); } \
    } } while (0)

#define XB_TMO      128
#define XB_XCNT(j)  (256  + 64 * (j))
#define XB_XSUB(j)  (1280 + 64 * (j))
#define XB_XGEN(j)  (2304 + 64 * (j))
#define XB_TOP      3328
#define XB_TOPGEN   3392
#define XCD_BAR_WORDS 3456
#define XB_SPIN_CAP (1u << 18)

__device__ __forceinline__ unsigned xb_ld(unsigned* p)              { return __hip_atomic_load(p, __ATOMIC_RELAXED, __HIP_MEMORY_SCOPE_AGENT); }
__device__ __forceinline__ unsigned xb_add(unsigned* p, unsigned v) { return __hip_atomic_fetch_add(p, v, __ATOMIC_RELAXED, __HIP_MEMORY_SCOPE_AGENT); }
__device__ __forceinline__ unsigned xb_xcc_id() { return (unsigned)__builtin_amdgcn_s_getreg((3 << 11) | 20) & 0xFu; }
#define XB_SPIN(cond, bar) do { unsigned _sp = 0; while (cond) { __builtin_amdgcn_s_sleep(1); \
    if ((++_sp & 255u) == 0u) { if (xb_ld(&(bar)[XB_TMO])) break; if (_sp > XB_SPIN_CAP) { atomicAdd(&(bar)[XB_TMO], 1u); break; } } } } while (0)

struct XcdBarrier {
    unsigned* bar; unsigned x;
    volatile LAS unsigned* st;
};

__device__ __forceinline__ XcdBarrier xcd_barrier_post(unsigned* bar, volatile LAS unsigned* st) {
    XcdBarrier b; b.bar = bar; b.x = xb_xcc_id(); b.st = st;
    if (threadIdx.x == 0) (void)xb_add(&bar[XB_XCNT(b.x)], 1u);
    return b;
}
__device__ __forceinline__ void xcd_barrier_complete(unsigned* bar, unsigned x, unsigned& nloc, unsigned& nx) {
    const unsigned G = gridDim.x * gridDim.y * gridDim.z;
    unsigned sum, cnt, mine, sp = 0u;
    for (;;) {
        sum = 0u; cnt = 0u; mine = 0u;
#pragma unroll
        for (unsigned j = 0; j < 16; ++j) { const unsigned c = xb_ld(&bar[XB_XCNT(j)]); sum += c; cnt += (c > 0u) ? 1u : 0u; mine = (j == x) ? c : mine; }
        if (sum == G) break;
        __builtin_amdgcn_s_sleep(1);
        if ((++sp & 255u) == 0u) { if (xb_ld(&bar[XB_TMO])) break; if (sp > XB_SPIN_CAP) { atomicAdd(&bar[XB_TMO], 1u); break; } }
    }
    nloc = mine > 0u ? mine : 1u; nx = cnt > 0u ? cnt : 1u;
}

__device__ __forceinline__ void xcd_barrier(const XcdBarrier& b_) {
    XcdBarrier b = b_; asm volatile("" : "+s"(b.bar), "+s"(b.x));
    asm volatile("s_waitcnt vmcnt(0)" ::: "memory");
    __syncthreads();
    if (threadIdx.x == 0) {
        unsigned* bar = b.bar;
        __builtin_amdgcn_s_waitcnt(0);
        unsigned nloc = b.st[0], nx = b.st[1];
        if (nloc == 0u) { xcd_barrier_complete(bar, b.x, nloc, nx); b.st[0] = nloc; b.st[1] = nx; }
        const unsigned old = xb_add(&bar[XB_XSUB(b.x)], 1u);
        const unsigned gen = old / nloc;
        if (old + 1u == (gen + 1u) * nloc) {
            __builtin_amdgcn_fence(__ATOMIC_RELEASE, "agent");
            asm volatile("s_waitcnt vmcnt(0)" ::: "memory");
            const unsigned og = xb_add(&bar[XB_TOP], 1u);
            const unsigned tg = og / nx;
            if (og + 1u == (tg + 1u) * nx) xb_add(&bar[XB_TOPGEN], 1u);
            else XB_SPIN(xb_ld(&bar[XB_TOPGEN]) == tg, bar);
            __builtin_amdgcn_fence(__ATOMIC_ACQUIRE, "agent");
            xb_add(&bar[XB_XGEN(b.x)], 1u);
            asm volatile("s_waitcnt vmcnt(0)" ::: "memory");
        } else {
            XB_SPIN(xb_ld(&bar[XB_XGEN(b.x)]) == gen, bar);
            __builtin_amdgcn_fence(__ATOMIC_ACQUIRE, "agent");
            asm volatile("s_waitcnt vmcnt(0)" ::: "memory");
        }
    }
    __syncthreads();
}


template <int RT, int NKS, class BOff> __device__ __forceinline__ void small_gemm(const bf16* A, int lda, const bf16* Bw, BOff boff, LAS float* red, int lane, int wave) {
    const int li = lane & 15, kq = lane >> 4, kbase = wave * (NKS * 32) + 8 * kq;
    f32x4 acc[RT][4];
#pragma unroll
    for (int rt = 0; rt < RT; ++rt)
#pragma unroll
        for (int ct = 0; ct < 4; ++ct) acc[rt][ct] = (f32x4){0.f, 0.f, 0.f, 0.f};
    const bf16* ap[RT];
#pragma unroll
    for (int rt = 0; rt < RT; ++rt) ap[rt] = A + (size_t)(16 * rt + li) * lda + kbase;
#pragma unroll
    for (int ks = 0; ks < NKS; ++ks) {
        bf16x8 a[RT], b[4];
#pragma unroll
        for (int rt = 0; rt < RT; ++rt) a[rt] = *(const bf16x8*)(ap[rt] + 32 * ks);
#pragma unroll
        for (int ct = 0; ct < 4; ++ct) b[ct] = *(const bf16x8*)(Bw + boff(16 * ct + li, kbase + 32 * ks));
#pragma unroll
        for (int rt = 0; rt < RT; ++rt)
#pragma unroll
            for (int ct = 0; ct < 4; ++ct) acc[rt][ct] = __builtin_amdgcn_mfma_f32_16x16x32_bf16(b[ct], a[rt], acc[rt][ct], 0, 0, 0);
    }
#pragma unroll
    for (int rt = 0; rt < RT; ++rt)
#pragma unroll
        for (int ct = 0; ct < 4; ++ct) *(LAS f32x4*)(red + ((size_t)wave * (16 * RT) + 16 * rt + li) * 64 + 16 * ct + 4 * kq) = acc[rt][ct];
}
__device__ __forceinline__ void st8g(bf16* p, const float (&o)[8]) { v4u w; w.x = pk2(o[0], o[1]); w.y = pk2(o[2], o[3]); w.z = pk2(o[4], o[5]); w.w = pk2(o[6], o[7]); *(v4u*)p = w; }

__device__ __forceinline__ void final_finish(const f32x4 (&v)[4], const float* g, float* orow, int lane) {
    float s = 0.f;
#pragma unroll
    for (int j = 0; j < 4; ++j) s += (v[j].x * v[j].x + v[j].y * v[j].y) + (v[j].z * v[j].z + v[j].w * v[j].w);
    const float r = rsqrtf(wave_sum(s) * (1.f / 1024.f) + EPS);
#pragma unroll
    for (int j = 0; j < 4; ++j) ((f32x4*)orow)[lane + 64 * j] = v[j] * r * ((const f32x4*)g)[lane + 64 * j];
}
__device__ __forceinline__ void panel_norm(unsigned* cnt, int pm, int pn, int vcu, const bf16* xlat, float* outf, const float* xctx, const float* gain, const float* modp, int shi, int sci, bf16* H, bool fin, bool doctx, int tid, int lane, int wave) {
    asm volatile("s_waitcnt vmcnt(0)" ::: "memory");
    __syncthreads();
    const int rt = vcu >> 4;
    if (tid == 0) {
        __builtin_amdgcn_fence(__ATOMIC_RELEASE, "agent"); asm volatile("s_waitcnt vmcnt(0)" ::: "memory");
        (void)xb_add(cnt + pm, 1u); (void)xb_add(cnt + 64 + rt, 1u);
        unsigned sp = 0; while (xb_ld(cnt + pm) < 4u || (doctx && xb_ld(cnt + 64 + rt) < 16u)) { __builtin_amdgcn_s_sleep(1); if (++sp > (1u << 22)) break; }
        __builtin_amdgcn_fence(__ATOMIC_ACQUIRE, "agent"); asm volatile("s_waitcnt vmcnt(0)" ::: "memory");
    }
    __syncthreads();
    const int s = pm < 32 ? 0 : 1;
    {
        const int r0 = 256 * pm + 64 * pn + 8 * wave;
        f32x4 v8[8][4], vc[4];
#pragma unroll
        for (int i = 0; i < 8; ++i) norm_load_bf(xlat + (size_t)(r0 + i) * 1024, lane, v8[i]);
        const int cr = 32 * rt + 2 * (vcu & 15) + (wave & 1);
        if (doctx && wave < 2) norm_load(xctx + (size_t)cr * 1024, lane, vc);
        asm volatile("" ::: "memory");
#pragma unroll
        for (int i = 0; i < 8; ++i) {
            if (fin) final_finish(v8[i], gain, outf + (size_t)(r0 + i) * 1024, lane);
            else norm_finish(v8[i], gain, modp + (size_t)(s * 6 + shi) * 1024, modp + (size_t)(s * 6 + sci) * 1024, H + (size_t)(r0 + i) * 1024, lane);
        }
        if (doctx && wave < 2) norm_finish(vc, gain, modp + (size_t)(2 * 6 + shi) * 1024, modp + (size_t)(2 * 6 + sci) * 1024, H + (size_t)(NLAT + cr) * 1024, lane);
    }
}

struct Args { const float* in[19]; float* out; unsigned char* ws; unsigned long long zero; };

__global__ void __launch_bounds__(NTHR, 2) fwd_megakernel(Args args) {
    extern __shared__ __attribute__((aligned(16))) unsigned char lds_raw[];
    cg::grid_group grid = cg::this_grid();
    LAS unsigned char* lds = (LAS unsigned char*)lds_raw;
    const int G = gridDim.x; const int bx = blockIdx.x;
    const int vcu = (G % 8 == 0) ? (bx % 8) * (G / 8) + bx / 8 : bx;
    const int NGW = G * NWAVES;
    constexpr int F_UNITS = (MROWS / 256) * (DUP / 256);
    const int f_rem = F_UNITS % G, n_idle = G - f_rem;
    const bool hide_conv = (f_rem != 0) && (n_idle >= 32);
#define PHASE_IDS() int tid_ = threadIdx.x; asm volatile("" : "+v"(tid_)); const int tid = tid_, lane = tid & 63, wave = __builtin_amdgcn_readfirstlane(tid >> 6), gw = vcu * NWAVES + wave; (void)tid; (void)lane; (void)wave; (void)gw

    unsigned char* const ws0 = args.ws;
#define PHASE_PTRS() GAS_ unsigned char* ws = (GAS_ unsigned char*)ws0; asm volatile("" : "+s"(ws)); GAS_ const float* GAS_ const* pt = (GAS_ const float* GAS_ const*)(ws + WS_PTRS); \
    const float* x_in = (const float*)pt[0]; const float* ctx_in = (const float*)pt[2]; const float* norm1_g = (const float*)pt[6]; const float* w_in = (const float*)pt[7]; const float* q_norm_g = (const float*)pt[8]; const float* k_norm_g = (const float*)pt[9]; \
    const float* gmlp_w = (const float*)pt[10]; const float* gmlp_b = (const float*)pt[11]; const float* conv_c_w = (const float*)pt[12]; const float* w_out = (const float*)pt[13]; const float* norm2_g = (const float*)pt[14]; const float* ffn_up = (const float*)pt[15]; \
    const float* ffn_conv_w = (const float*)pt[16]; const float* ffn_down = (const float*)pt[17]; const float* final_g = (const float*)pt[18]; float* out = (float*)pt[19]; \
    float* MODV = (float*)(ws + WS_MODV); f32x2* ROPE = (f32x2*)(ws + WS_ROPE); float* XSC = (float*)(ws + WS_XSC); \
    GAS_ unsigned char* wl_ = ws + ((l & 1) ? WS_W1 : WS_W0); bf16* XB = (bf16*)(ws + WS_XB); (void)XB; bf16* WIN = (bf16*)(wl_ + WO_WIN); bf16* WOUT = (bf16*)(wl_ + WO_WOUT); bf16* WUP = (bf16*)(wl_ + WO_WUP); bf16* WDN = (bf16*)(wl_ + WO_WDN); unsigned* CNT = (unsigned*)(ws + WS_CNT); \
    bf16* ACT = (bf16*)(ws + WS_ACT); bf16* H = (bf16*)(ws + WS_H); float* HALO = (float*)(ws + WS_HALO); \
    bf16* Qb = (bf16*)(ws + WS_Q); bf16* Kb = (bf16*)(ws + WS_K); bf16* Vb = (bf16*)(ws + WS_V); bf16* Ub = (bf16*)(ws + WS_U); \
    bf16* VNb = (bf16*)(ws + WS_VN); bf16* CBb = (bf16*)(ws + WS_CB); bf16* CCHb = (bf16*)(ws + WS_CCH); bf16* MIX = (bf16*)(ws + WS_MIX); \
    const float* modl = MODV + (size_t)l * 3 * 6144; const float* cur_ctx = (l == 0) ? ctx_in : XSC; \
    (void)x_in; (void)ctx_in; (void)norm1_g; (void)w_in; (void)q_norm_g; (void)k_norm_g; (void)gmlp_w; (void)gmlp_b; (void)conv_c_w; (void)w_out; (void)norm2_g; (void)ffn_up; (void)ffn_conv_w; (void)ffn_down; (void)final_g; (void)out; \
    (void)CNT; (void)MODV; (void)ROPE; (void)XSC; (void)WIN; (void)WOUT; (void)WUP; (void)WDN; (void)ACT; (void)H; (void)HALO; (void)Qb; (void)Kb; (void)Vb; (void)Ub; (void)VNb; (void)CBb; (void)CCHb; (void)MIX; (void)modl; (void)cur_ctx
    unsigned char* ws = args.ws;
    if (bx == 0 && threadIdx.x < 20) { const float* p = threadIdx.x < 19 ? args.in[threadIdx.x] : (const float*)args.out; ((const float**)(ws + WS_PTRS))[threadIdx.x] = p; }
    const float* c_in = args.in[1]; const float* cctx_in = args.in[3]; const float* w_mod = args.in[4]; const float* b_mod = args.in[5];
    float* MODV = (float*)(ws + WS_MODV); f32x2* ROPE = (f32x2*)(ws + WS_ROPE);
    unsigned* barw = (unsigned*)(ws + WS_BAR);
    { const int t0 = threadIdx.x;
      for (int u = t0; u < (LDS_BYTES - RING_BYTES) / 4; u += NTHR) ((LAS unsigned*)(lds + RING_BYTES))[u] = 0u;
    }
    __syncthreads();
    const XcdBarrier xbar = xcd_barrier_post(barw, (volatile LAS unsigned*)(lds + RING_BYTES + 64));
#ifndef SKIP_P0
        for (int rep_ = 0; rep_ < REP_P0; ++rep_) { if (rep_) __syncthreads();
        { PHASE_IDS();
    {
        LAS float* sc = (LAS float*)lds;
        LAS float* part = (LAS float*)(lds + 16384);
        for (int i = tid; i < 3072; i += NTHR) { const int s = i >> 10, k = i & 1023; const float cv = s < 2 ? c_in[s * 1024 + k] : cctx_in[k]; sc[i] = silu_f(cv); }
        __syncthreads();
        for (int unit = vcu; unit < NLAYER * 192; unit += G) {
            const int l = unit / 192, j0 = (unit % 192) * 32, hlf = lane >> 5, cl = lane & 31, k0 = wave * 128 + hlf * 64;
            const float* wp = w_mod + (size_t)l * 1024 * 6144 + (size_t)k0 * 6144 + j0 + cl;
            float a0 = 0.f, a1 = 0.f, a2 = 0.f;
#pragma unroll 32
            for (int k = 0; k < 64; ++k) { const float wv = wp[(size_t)k * 6144]; a0 += sc[k0 + k] * wv; a1 += sc[1024 + k0 + k] * wv; a2 += sc[2048 + k0 + k] * wv; }
            a0 += __shfl_xor(a0, 32); a1 += __shfl_xor(a1, 32); a2 += __shfl_xor(a2, 32);
            if (lane < 32) { part[(wave * 3 + 0) * 32 + cl] = a0; part[(wave * 3 + 1) * 32 + cl] = a1; part[(wave * 3 + 2) * 32 + cl] = a2; }
            __syncthreads();
            if (tid < 96) { const int s = tid >> 5, j = tid & 31; float t = b_mod[l * 6144 + j0 + j];
#pragma unroll
                for (int w = 0; w < 8; ++w) t += part[(w * 3 + s) * 32 + j];
                MODV[(size_t)(l * 3 + s) * 6144 + j0 + j] = t; }
            __syncthreads();
        }
        if (bx == 0) {
            for (int e = tid; e < 2048; e += NTHR) {
                const int pos = e >> 4, f = e & 15;
                double th = 1.0; for (int i = 0; i < f; ++i) th *= 0.5623413251903491;
                const double a = (double)pos * th;
                const double kk = __builtin_rint(a * 0.15915494309189535);
                const double xr = (a - kk * 6.283185307179586) - kk * 2.4492935982947064e-16;
                const double x2 = xr * xr; double sn = xr, cs = 1.0, ts = xr, tc = 1.0;
                for (int n = 1; n <= 14; ++n) { tc *= -x2 / (double)((2 * n - 1) * (2 * n)); cs += tc; ts *= -x2 / (double)((2 * n) * (2 * n + 1)); sn += ts; }
                ROPE[e] = (f32x2){(float)cs, (float)sn};
            }
        }
        __syncthreads();
        {
            LAS float* scr = (LAS float*)(lds + wave * 16384);
            const float* w_in = args.in[7]; const float* w_out = args.in[13]; const float* ffn_up = args.in[15]; const float* ffn_down = args.in[17];
            const int nl = 1;
            for (int it = gw; it < nl * CONV_ITEMS; it += NGW) { const int l = it / CONV_ITEMS; convert_item(it - l * CONV_ITEMS, l, w_in, w_out, ffn_up, ffn_down, ws, scr, lane); }
        }
    }
        }
        }
#endif
    if (args.zero) grid.sync();
    xcd_barrier(xbar);

    const bool fused = (G == 256);
    { PHASE_IDS(); const int l = 0; PHASE_PTRS();
      for (int m = gw; m < MROWS; m += NGW) {
          f32x4 va[4]; const int s_ = m < SEQL ? 0 : (m < NLAT ? 1 : 2);
          if (m < NLAT) { norm_load(x_in + (size_t)m * 1024, lane, va); v2u* xo = (v2u*)(XB + (size_t)m * 1024) + lane;
#pragma unroll
              for (int j = 0; j < 4; ++j) { v2u w; w.x = pk2(va[j].x, va[j].y); w.y = pk2(va[j].z, va[j].w); xo[64 * j] = w; } }
          else norm_load(ctx_in + (size_t)(m - NLAT) * 1024, lane, va);
          norm_finish(va, norm1_g, modl + (size_t)(s_ * 6 + 0) * 1024, modl + (size_t)(s_ * 6 + 1) * 1024, H + (size_t)m * 1024, lane);
      }
    }
    xcd_barrier(xbar);
#pragma unroll 1
    for (int l = 0; l < NLAYER; ++l) {
#ifndef SKIP_PB
        for (int rep_ = 0; rep_ < REP_PB; ++rep_) { if (rep_) xcd_barrier(xbar);
        {
            PHASE_PTRS();
            pg8::Gemm g{H, WIN, NLAT, DIN, 1024}; pg8::StaticOrder S; S.init(NLAT, DIN, G, bx);
            pg8::EpiProj E{Qb, Kb, Vb, Ub, VNb, CBb, CCHb, q_norm_g + l * 64, k_norm_g + l * 64, ROPE};
            pg8::gemm_phase<pg8::EpiProj, pg8::StaticOrder, PG8_ALIGN, PG8_SP2>(lds, g, S, E);
        }
        {
            PHASE_IDS(); PHASE_PTRS();
            LAS float* red = (LAS float*)lds;
            for (int tile = vcu; tile < 256; tile += G) {
                const int rtile = tile >> 5, T = (tile >> 2) & 7, wc = tile & 3;
                small_gemm<4, 4>(H + (size_t)(NLAT + 64 * rtile) * 1024, 1024, WIN, [&](int c, int k) { return pg8::wt_off(256 * T + 128 * (c >> 5) + 32 * wc + (c & 31), k, 16, true); }, red, lane, wave);
                __syncthreads();
                const int r = tid >> 3, d0 = (tid & 7) * 8; const int cr = 64 * rtile + r, gm = NLAT + cr;
                float v[8];
#pragma unroll
                for (int k = 0; k < 8; ++k) v[k] = 0.f;
#pragma unroll
                for (int w = 0; w < 8; ++w) { const f32x4 p0 = *(const LAS f32x4*)(red + ((size_t)w * 64 + r) * 64 + d0), p1 = *(const LAS f32x4*)(red + ((size_t)w * 64 + r) * 64 + d0 + 4);
                    v[0] += p0.x; v[1] += p0.y; v[2] += p0.z; v[3] += p0.w; v[4] += p1.x; v[5] += p1.y; v[6] += p1.z; v[7] += p1.w; }
                const int kvb = cr >> 8, kvr = cr & 255;
                float o[8];
                if (T == 0) {
#pragma unroll
                    for (int k = 0; k < 8; ++k) o[k] = gelu_t(v[k]);
                    st8g(Ub + (size_t)gm * 256 + 64 * wc + d0, o);
                } else if (T == 1) {
                    float sm = 0.f;
#pragma unroll
                    for (int k = 0; k < 8; ++k) { v[k] = gelu_t(v[k]); sm += v[k]; }
                    sm += __shfl_xor(sm, 1); sm += __shfl_xor(sm, 2); sm += __shfl_xor(sm, 4);
                    const float mean = sm * (1.f / 64.f); float q = 0.f;
#pragma unroll
                    for (int k = 0; k < 8; ++k) { v[k] -= mean; q += v[k] * v[k]; }
                    q += __shfl_xor(q, 1); q += __shfl_xor(q, 2); q += __shfl_xor(q, 4);
                    const float rstd = rsqrtf(q * (1.f / 64.f) + EPS);
#pragma unroll
                    for (int k = 0; k < 8; ++k) o[k] = v[k] * rstd;
                    st8g(VNb + (size_t)gm * 256 + 64 * wc + d0, o);
                } else if (T == 2 || T == 3 || (T == 4 && wc < 2)) {
                    float ss = 0.f;
#pragma unroll
                    for (int k = 0; k < 8; ++k) ss += v[k] * v[k];
                    ss += __shfl_xor(ss, 1); ss += __shfl_xor(ss, 2); ss += __shfl_xor(ss, 4);
                    const float rr = rsqrtf(ss * (1.f / 64.f) + EPS);
                    const float* gp = (T == 4 ? k_norm_g : q_norm_g) + l * 64 + d0; const float osc = (T == 4) ? 1.f : QSCALE;
#pragma unroll
                    for (int k = 0; k < 8; ++k) o[k] = v[k] * rr * gp[k] * osc;
                    if (T == 4) st8g(Kb + ((((size_t)(kvb * 2 + wc) * (KVROWS / 64) + (kvr >> 6)) * 8 + (d0 >> 3)) * 64 + (kvr & 63)) * 8, o); else st8g(Qb + (size_t)gm * 512 + 64 * (4 * (T - 2) + wc) + d0, o);
                } else if (T == 4) {
                    st8g(Vb + ((((size_t)(kvb * 2 + wc - 2) * (KVROWS / 64) + (kvr >> 6)) * 8 + ((d0 >> 5) * 4 + ((kvr >> 4) & 3))) * 16 + (kvr & 15)) * 32 + (d0 & 31), v);
                } else if (T == 5) {
                    st8g(CBb + (size_t)gm * 256 + 64 * wc + d0, v);
                } else {
#pragma unroll
                    for (int k = 0; k < 8; ++k) o[k] = v[k] * __shfl_xor(v[k], 4);
                    if (d0 < 32) st8g(CCHb + (size_t)gm * 256 + 128 * (T - 6) + 32 * wc + d0, o);
                }
                __syncthreads();
            }
        }
        }
#endif
        xcd_barrier(xbar);
#ifndef SKIP_PC
        for (int rep_ = 0; rep_ < REP_PC; ++rep_) { if (rep_) xcd_barrier(xbar);
        { PHASE_IDS(); PHASE_PTRS();
        {
            float gqm = fabsf(q_norm_g[l * 64 + lane]), gkm = fabsf(k_norm_g[l * 64 + lane]);
#pragma unroll
            for (int o = 1; o < 64; o <<= 1) { gqm = fmaxf(gqm, __shfl_xor(gqm, o)); gkm = fmaxf(gkm, __shfl_xor(gkm, o)); }
            const float mstat = __builtin_amdgcn_readfirstlane(64.f * QSCALE * 1.01f * gqm * gkm);
            const bool use_static = mstat <= 30.f;
            for (int i = 0;; ++i) {
                const int u = vcu + i * G; if (u >= (l == NLAYER - 1 ? 512 : 528)) break;
                const attn_body::bf16 *Qu, *Kh, *Vh; attn_body::bf16* Ou; int NT;
                if (u < 512) { const int bg = u >> 7, b = bg >> 1, g = bg & 1, rem = u & 127, qh = g * 4 + (rem >> 5), qb = rem & 31;
                    const size_t r0 = (size_t)b * SEQL + qb * 256;
                    Qu = (const attn_body::bf16*)Qb + r0 * 512 + qh * 64; Ou = (attn_body::bf16*)MIX + r0 * 1024 + 256 + qh * 64;
                    Kh = (const attn_body::bf16*)Kb + (size_t)(b * 2 + g) * (KVROWS / 64) * 4096; Vh = (const attn_body::bf16*)Vb + (size_t)(b * 2 + g) * (KVROWS / 64) * 4096; NT = KVROWS / 64;
                } else { const int j = u - 512, b = j >> 3, qh = j & 7, g = qh >> 2;
                    const size_t r0 = (size_t)NLAT + b * CTXL;
                    Qu = (const attn_body::bf16*)Qb + r0 * 512 + qh * 64; Ou = (attn_body::bf16*)MIX + r0 * 1024 + 256 + qh * 64;
                    Kh = (const attn_body::bf16*)Kb + (size_t)(b * 2 + g) * (KVROWS / 64) * 4096; Vh = (const attn_body::bf16*)Vb + (size_t)(b * 2 + g) * (KVROWS / 64) * 4096; NT = CTXL / 64;
                }
                if (use_static) attn_body::attn_unit<8, true>(Qu, 512, Kh, Vh, 128, NT, Ou, 1024, (char*)lds_raw, mstat);
                else attn_body::attn_unit<8, false>(Qu, 512, Kh, Vh, 128, NT, Ou, 1024, (char*)lds_raw, 0.f);
            }
            __syncthreads();
            {
                constexpr int VP = 72;
                LAS bf16* vt = (LAS bf16*)lds;
                for (int unit = (vcu + G / 2) % G; unit < ((l == NLAYER - 1 ? NLAT : MROWS) / 128) * 4; unit += G) {
                    const int ck = unit >> 2, h = unit & 3, m0 = ck * 128;
                    const int pi = lane & 15, kq = lane >> 4, p = wave * 16 + pi;
                    const float* wrow = gmlp_w + ((size_t)(l * 4 + h) * 128 + p) * 128;
                    const int trow = tid >> 2, chk = tid & 3; const bf16* src = VNb + (size_t)(m0 + trow) * 256 + h * 64 + chk * 16;
                    const v4u ta = *(const v4u*)src, tb = *(const v4u*)(src + 8);
                    f32x4 wf[4][2];
#pragma unroll
                    for (int ks = 0; ks < 4; ++ks) { wf[ks][0] = *(const f32x4*)(wrow + 32 * ks + 8 * kq); wf[ks][1] = *(const f32x4*)(wrow + 32 * ks + 8 * kq + 4); }
                    const float bias = gmlp_b[(l * 4 + h) * 128 + p];
                    v2u ug[4];
#pragma unroll
                    for (int nt = 0; nt < 4; ++nt) ug[nt] = *(const v2u*)(Ub + (size_t)(m0 + p) * 256 + h * 64 + 16 * nt + 4 * kq);
                    *(LAS v4u*)(vt + trow * VP + chk * 16) = ta; *(LAS v4u*)(vt + trow * VP + chk * 16 + 8) = tb;
                    __syncthreads();
                    bf16x8 bfr[4];
#pragma unroll
                    for (int ks = 0; ks < 4; ++ks) { const f32x4 w0 = wf[ks][0], w1 = wf[ks][1];
                        v4u t; t.x = pk2(w0.x, w0.y); t.y = pk2(w0.z, w0.w); t.z = pk2(w1.x, w1.y); t.w = pk2(w1.z, w1.w); bfr[ks] = __builtin_bit_cast(bf16x8, t); }
#pragma unroll
                    for (int nt = 0; nt < 4; ++nt) {
                        f32x4 d = {0.f, 0.f, 0.f, 0.f};
#pragma unroll
                        for (int ks = 0; ks < 4; ++ks) { bf16x8 af;
#pragma unroll
                            for (int jj = 0; jj < 8; ++jj) af[jj] = (short)vt[(32 * ks + 8 * kq + jj) * VP + 16 * nt + pi];
                            d = __builtin_amdgcn_mfma_f32_16x16x32_bf16(af, bfr[ks], d, 0, 0, 0); }
                        const size_t row = (size_t)(m0 + p); const int dc = h * 64 + 16 * nt + 4 * kq;
                        const v2u uu = ug[nt];
                        v2u o; o.x = pk2(bf_lo(uu.x) * (d[0] + bias), bf_hi(uu.x) * (d[1] + bias)); o.y = pk2(bf_lo(uu.y) * (d[2] + bias), bf_hi(uu.y) * (d[3] + bias));
                        *(v2u*)(MIX + row * 1024 + dc) = o;
                    }
                    __syncthreads();
                }
            }
            {
                const f32x4 w0 = ((const f32x4*)(conv_c_w + (size_t)l * 768))[lane], w1 = ((const f32x4*)(conv_c_w + (size_t)l * 768 + 256))[lane], w2 = ((const f32x4*)(conv_c_w + (size_t)l * 768 + 512))[lane];
                const int rows_per = (MROWS + G - 1) / G;
                constexpr int CU_ = 9;
                for (int i0 = wave; i0 < rows_per; i0 += NWAVES * CU_) {
                    v2u cm[CU_], cp[CU_], cn[CU_], cb[CU_]; int mm[CU_];
#pragma unroll
                    for (int u = 0; u < CU_; ++u) {
                        const int i = i0 + NWAVES * u; int m = vcu * rows_per + i; if (i >= rows_per || m >= (l == NLAYER - 1 ? NLAT : MROWS)) m = -1;
                        mm[u] = m; const int mc = m < 0 ? 0 : m;
                        const int t = mc < NLAT ? (mc & (SEQL - 1)) : ((mc - NLAT) & (CTXL - 1)); const int L = mc < NLAT ? SEQL : CTXL;
                        const v2u z = {0u, 0u};
                        cm[u] = *(const v2u*)(CCHb + (size_t)mc * 256 + 4 * lane);
                        cp[u] = t > 0 ? *(const v2u*)(CCHb + (size_t)(mc - 1) * 256 + 4 * lane) : z;
                        cn[u] = t < L - 1 ? *(const v2u*)(CCHb + (size_t)(mc + 1) * 256 + 4 * lane) : z;
                        cb[u] = *(const v2u*)(CBb + (size_t)mc * 256 + 4 * lane);
                    }
#pragma unroll
                    for (int u = 0; u < CU_; ++u) {
                        if (mm[u] < 0) continue;
                        const float o0 = bf_lo(cb[u].x) * (w0.x * bf_lo(cp[u].x) + w1.x * bf_lo(cm[u].x) + w2.x * bf_lo(cn[u].x));
                        const float o1 = bf_hi(cb[u].x) * (w0.y * bf_hi(cp[u].x) + w1.y * bf_hi(cm[u].x) + w2.y * bf_hi(cn[u].x));
                        const float o2 = bf_lo(cb[u].y) * (w0.z * bf_lo(cp[u].y) + w1.z * bf_lo(cm[u].y) + w2.z * bf_lo(cn[u].y));
                        const float o3 = bf_hi(cb[u].y) * (w0.w * bf_hi(cp[u].y) + w1.w * bf_hi(cm[u].y) + w2.w * bf_hi(cn[u].y));
                        v2u o; o.x = pk2(o0, o1); o.y = pk2(o2, o3);
                        *(v2u*)(MIX + (size_t)mm[u] * 1024 + 768 + 4 * lane) = o;
                    }
                }
            }
        }
        }
        }
#endif
        xcd_barrier(xbar);
#ifndef SKIP_PD
        {
            PHASE_PTRS();
            pg8::Gemm g{MIX, WOUT, NLAT, 1024, 1024}; pg8::StaticOrder S; S.init(NLAT, 1024, G, bx);
            pg8::EpiResid E{XB, XB, modl, 2};
            pg8::gemm_phase<pg8::EpiResid, pg8::StaticOrder, PG8_ALIGN, PG8_SP2>(lds, g, S, E);
        }
        {
            PHASE_IDS(); PHASE_PTRS();
            LAS float* red = (LAS float*)lds;
            for (int tile = vcu; tile < (l == NLAYER - 1 ? 0 : 256); tile += G) {
                const int rtile = tile >> 4, ctile = tile & 15;
                small_gemm<2, 4>(MIX + (size_t)(NLAT + 32 * rtile) * 1024, 1024, WOUT, [&](int c, int k) { return pg8::wt_off(64 * ctile + c, k, 16, true); }, red, lane, wave);
                __syncthreads();
                const int r = tid >> 4, c0 = (tid & 15) * 4; const int cr = 32 * rtile + r, col = 64 * ctile + c0;
                f32x4 v = {0.f, 0.f, 0.f, 0.f};
#pragma unroll
                for (int w = 0; w < 8; ++w) v += *(const LAS f32x4*)(red + ((size_t)w * 32 + r) * 64 + c0);
                const f32x4 gt = *(const f32x4*)(modl + (size_t)(2 * 6 + 2) * 1024 + col);
                const f32x4 b = *(const f32x4*)(cur_ctx + (size_t)cr * 1024 + col);
                *(f32x4*)(XSC + (size_t)cr * 1024 + col) = b + gt * v;
                __syncthreads();
            }
        }
        if (fused) { PHASE_IDS(); PHASE_PTRS();
            pg8::StaticOrder S2; S2.init(NLAT, 1024, G, bx); pg8::Unit u2; (void)S2.next(0, u2);
            panel_norm(CNT + (l * 2 + 0) * 128, u2.pm, u2.pn, vcu, XB, out, XSC, norm2_g + l * 1024, modl, 3, 4, H, false, l < NLAYER - 1, tid, lane, wave);
        }
#endif
        xcd_barrier(xbar);
        if (!fused) { { PHASE_IDS(); PHASE_PTRS(); NORM_ROWS(XB, XSC, norm2_g + l * 1024, modl, 3, 4); } xcd_barrier(xbar); }
#ifndef SKIP_PF
        for (int rep_ = 0; rep_ < REP_PF; ++rep_) { if (rep_) xcd_barrier(xbar);
        {
            PHASE_PTRS();
            const int mf = (l == NLAYER - 1) ? NLAT : MROWS;
            pg8::Gemm g{H, WUP, mf, DUP, 1024}; pg8::StaticOrder S; S.init(mf, DUP, G, bx);
            pg8::EpiUpConv E{ACT, HALO, ffn_conv_w + (size_t)l * 3 * DUP};
            pg8::gemm_phase<pg8::EpiUpConv, pg8::StaticOrder, PG8_ALIGN, PG8_SP2>(lds, g, S, E);
            if (hide_conv && l + 1 < NLAYER && bx >= f_rem) {
                PHASE_IDS(); LAS float* scr = (LAS float*)(lds + wave * 16384);
                for (int it = (bx - f_rem) * NWAVES + wave; it < CONV_ITEMS; it += n_idle * NWAVES) convert_item(it, l + 1, w_in, w_out, ffn_up, ffn_down, (unsigned char*)ws, scr, lane);
            }
            if (!hide_conv && l + 1 < NLAYER) { PHASE_IDS(); LAS float* scr = (LAS float*)(lds + wave * 16384);
                for (int it = gw; it < CONV_ITEMS; it += NGW) convert_item(it, l + 1, w_in, w_out, ffn_up, ffn_down, (unsigned char*)ws, scr, lane); }
        }
        }
#endif
        xcd_barrier(xbar);
#ifndef SKIP_PG
        { PHASE_IDS(); PHASE_PTRS();
            const float* cw = ffn_conv_w + (size_t)l * 3 * DUP;
            for (int tk = gw; tk < 11 * 2 * ((l == NLAYER - 1 ? NLAT : MROWS) / 128 - 1); tk += NGW) {
                const int task = tk / 11, it = tk - 11 * task; const int S = 1 + (task >> 1), which = task & 1, R = 128 * S;
                const bool boundary = R < NLAT ? ((R & (SEQL - 1)) == 0) : (((R - NLAT) & (CTXL - 1)) == 0);
                if (boundary) continue;
                const float* hp = HALO + (size_t)((S - 1) * 4 + 2 + which) * DUP;
                const int row = R - 1 + which;
                {
                    const int c = 4 * (lane + 64 * it);
                    const f32x4 ap = *(const f32x4*)(hp + c), am = *(const f32x4*)(hp + DUP + c), an = *(const f32x4*)(hp + 2 * DUP + c);
                    const f32x4 gp = *(const f32x4*)(hp + DFF + c), gmv = *(const f32x4*)(hp + DUP + DFF + c), gn = *(const f32x4*)(hp + 2 * DUP + DFF + c);
                    const f32x4 wa0 = *(const f32x4*)(cw + c), wa1 = *(const f32x4*)(cw + DUP + c), wa2 = *(const f32x4*)(cw + 2 * DUP + c);
                    const f32x4 wg0 = *(const f32x4*)(cw + DFF + c), wg1 = *(const f32x4*)(cw + DUP + DFF + c), wg2 = *(const f32x4*)(cw + 2 * DUP + DFF + c);
                    const f32x4 ca = wa0 * ap + wa1 * am + wa2 * an, cg = wg0 * gp + wg1 * gmv + wg2 * gn;
                    v2u o; o.x = pk2(silu_f(cg.x) * ca.x, silu_f(cg.y) * ca.y); o.y = pk2(silu_f(cg.z) * ca.z, silu_f(cg.w) * ca.w);
                    *(v2u*)(ACT + (size_t)row * DFF + c) = o;
                }
            }
        }
#endif
        xcd_barrier(xbar);
#ifndef SKIP_PH
        {
            PHASE_PTRS();
            pg8::Gemm g{ACT, WDN, NLAT, 1024, DFF}; pg8::StaticOrder S; S.init(NLAT, 1024, G, bx);
            pg8::EpiResid E{XB, XB, modl, 5};
            pg8::gemm_phase<pg8::EpiResid, pg8::StaticOrder, PG8_ALIGN, PG8_SP2>(lds, g, S, E);
        }
        {
            PHASE_IDS(); PHASE_PTRS();
            LAS float* red = (LAS float*)lds;
            for (int tile = vcu; tile < (l == NLAYER - 1 ? 0 : 256); tile += G) {
                const int rtile = tile >> 4, ctile = tile & 15;
                small_gemm<2, 11>(ACT + (size_t)(NLAT + 32 * rtile) * 2816, 2816, WDN, [&](int c, int k) { return pg8::wt_off(64 * ctile + c, k, 44, true); }, red, lane, wave);
                __syncthreads();
                const int r = tid >> 4, c0 = (tid & 15) * 4; const int cr = 32 * rtile + r, col = 64 * ctile + c0;
                f32x4 v = {0.f, 0.f, 0.f, 0.f};
#pragma unroll
                for (int w = 0; w < 8; ++w) v += *(const LAS f32x4*)(red + ((size_t)w * 32 + r) * 64 + c0);
                const f32x4 gt = *(const f32x4*)(modl + (size_t)(2 * 6 + 5) * 1024 + col);
                const f32x4 b = *(const f32x4*)(XSC + (size_t)cr * 1024 + col);
                *(f32x4*)(XSC + (size_t)cr * 1024 + col) = b + gt * v;
                __syncthreads();
            }
        }
        if (fused) { PHASE_IDS(); PHASE_PTRS();
            pg8::StaticOrder S2; S2.init(NLAT, 1024, G, bx); pg8::Unit u2; (void)S2.next(0, u2);
            const bool fin = (l == NLAYER - 1); const int ln = fin ? l : l + 1;
            panel_norm(CNT + (l * 2 + 1) * 128, u2.pm, u2.pn, vcu, XB, out, XSC, fin ? final_g : norm1_g + ln * 1024, MODV + (size_t)ln * 3 * 6144, 0, 1, H, fin, !fin, tid, lane, wave);
        }
#endif
        if (fused && l == NLAYER - 1) break;
        xcd_barrier(xbar);
        if (!fused) { PHASE_IDS(); PHASE_PTRS();
            if (l < NLAYER - 1) { NORM_ROWS(XB, XSC, norm1_g + (l + 1) * 1024, MODV + (size_t)(l + 1) * 3 * 6144, 0, 1); }
            else {
                for (int m = gw; m < NLAT; m += NGW) { f32x4 va[4]; norm_load_bf(XB + (size_t)m * 1024, lane, va); final_finish(va, final_g, out + (size_t)m * 1024, lane); }
            }
            if (l < NLAYER - 1) xcd_barrier(xbar);
        }
    }
}

extern "C" void kernel_launch(void* const* d_in, const int* in_sizes, int n_in, void* d_out, int out_size, void* d_ws, size_t ws_size, hipStream_t stream) {
    static int grid = 0;
    if (grid == 0) {
        if (n_in != 19 || out_size != NLAT * DMOD || ws_size < WS_END) { fprintf(stderr, "kernel_launch: unexpected shapes (n_in %d out %d ws %zu need %zu)\n", n_in, out_size, ws_size, (size_t)WS_END); grid = -1; return; }
        int dev = 0, cus = 0, per_cu = 0;
        hipGetDevice(&dev); hipDeviceGetAttribute(&cus, hipDeviceAttributeMultiprocessorCount, dev);
        if (hipFuncSetAttribute((const void*)fwd_megakernel, hipFuncAttributeMaxDynamicSharedMemorySize, LDS_BYTES) != hipSuccess) { fprintf(stderr, "kernel_launch: hipFuncSetAttribute failed\n"); grid = -1; return; }
        if (hipOccupancyMaxActiveBlocksPerMultiprocessor(&per_cu, (const void*)fwd_megakernel, NTHR, LDS_BYTES) != hipSuccess || per_cu < 1) { fprintf(stderr, "kernel_launch: occupancy query says %d\n", per_cu); per_cu = 1; }
        (void)hipGetLastError();
        grid = cus;
    }
    if (grid < 0) return;
    if (hipMemsetAsync((char*)d_ws + WS_BAR, 0, WS_CNT + 4096 - WS_BAR, stream) != hipSuccess) { fprintf(stderr, "kernel_launch: hipMemsetAsync failed\n"); return; }
    Args a{};
    for (int i = 0; i < 19; ++i) a.in[i] = (const float*)d_in[i];
    a.out = (float*)d_out; a.ws = (unsigned char*)d_ws;
    void* kargs[] = {&a};
    hipError_t e = hipLaunchCooperativeKernel((const void*)fwd_megakernel, dim3(grid), dim3(NTHR), kargs, LDS_BYTES, stream);
    if (e != hipSuccess) fprintf(stderr, "kernel_launch: cooperative launch failed: %s (grid %d)\n", hipGetErrorString(e), grid);
}
```

```cpp
#include <hip/hip_runtime.h>
#include <cstdio>
#include <cstdint>
namespace pg8 {
#define PG8_LAS __attribute__((address_space(3)))
typedef unsigned short bf16_t;
typedef short bf16x8 __attribute__((ext_vector_type(8)));
typedef float f32x4 __attribute__((ext_vector_type(4)));
typedef unsigned u32x4 __attribute__((ext_vector_type(4)));
constexpr int BM = 256, BK = 64, HALF = 128, HTB = HALF * BK * 2  , STAGE_BYTES = 8 * HTB, NXCD = 8, WGM = 8;

__host__ __device__ __forceinline__ int lds_byte(int r, int c) { const int st = (r >> 4) * 2 + (c >> 5), rr = r & 15, cc = c & 31, ob = rr * 64 + cc * 2; return st * 1024 + (ob ^ (((ob >> 9) & 1) << 5)); }
__host__ __device__ __forceinline__ void stage_rc(int b, int& R, int& C) { const int st = b / 1024, sb = b % 1024, swz = sb ^ (((sb >> 9) & 1) << 5); R = (st >> 1) * 16 + swz / 64; C = (st & 1) * 32 + (swz % 64) / 2; }
__host__ __device__ __forceinline__ int perm32(int rho) { const int n = rho >> 4, i = rho & 15; return 8 * (i >> 2) + 4 * n + (i & 3); }

__host__ __device__ __forceinline__ size_t wt_off(int P, int k, int nt, bool perm) {
    const int p = P & 127, x = p & 31, R = perm ? ((p & ~31) + 16 * ((x >> 2) & 1) + 4 * (x >> 3) + (x & 3)) : p;
    return ((size_t)(((P >> 8) * nt + (k >> 6)) * 2 + ((P >> 7) & 1)) * 16384 + (size_t)lds_byte(R, k & 63)) >> 1;
}
struct Unit { int pm, pn; };
struct Gemm { const bf16_t* A; const bf16_t* Bt; int M, N, K; };

struct StaticOrder {
    int nM, nN, nwg, G, c;
    __host__ __device__ __forceinline__ void init(int M, int N, int G_, int c_) { nM = M / BM; nN = N / BM; nwg = nM * nN; G = G_; c = c_; }
    __host__ __device__ __forceinline__ bool next(int i, Unit& u) const {
        const long L = (long)i * G + c; if (L >= nwg) return false;
        int wgid = (int)L; { const int q = nwg / NXCD, r = nwg % NXCD, xcd = wgid % NXCD, off = wgid / NXCD; wgid = (xcd < r ? xcd * (q + 1) : r * (q + 1) + (xcd - r) * q) + off; }
        const int nig = WGM * nN, gid = wgid / nig, fm = gid * WGM, gsz = (nM - fm) < WGM ? (nM - fm) : WGM;
        u.pm = fm + ((wgid % nig) % gsz); u.pn = (wgid % nig) / gsz; return true;
    }
    __device__ __forceinline__ void a_ready(const Unit&) const {}
    __device__ __forceinline__ void done(const Unit&) const {}
};

__device__ __forceinline__ unsigned cvt_pk_bf16(float lo, float hi) { unsigned r; asm volatile("v_cvt_pk_bf16_f32 %0, %1, %2" : "=v"(r) : "v"(lo), "v"(hi)); return r; }
typedef float f32x2 __attribute__((ext_vector_type(2)));
__device__ __forceinline__ f32x2 gelu_pk(f32x2 v) {
    const f32x2 av = __builtin_elementwise_abs(v), d = av * 0.2316418882f + 1.0f;
    f32x2 t; t.x = __builtin_amdgcn_rcpf(d.x); t.y = __builtin_amdgcn_rcpf(d.y);
    f32x2 q = t * 0.5307027145f + (-0.7265760135f); q = q * t + 0.7107068705f; q = q * t + (-0.142248368f); q = q * t + 0.127414796f; q = q * t;
    const f32x2 s = (v * v) * (-0.72134752044f);
    f32x2 e; e.x = __builtin_amdgcn_exp2f(s.x); e.y = __builtin_amdgcn_exp2f(s.y);
    const f32x2 m = v * (q * e), r = v - m;
    f32x2 o; o.x = v.x < 0.f ? m.x : r.x; o.y = v.y < 0.f ? m.y : r.y; return o;
}

template <int ACT  > struct EpiBf16 {
    static constexpr bool PERM = true, AFTER_DRAIN = false, ROWPERM = false; static_assert(ACT == 0 || ACT == 1, "EpiBf16: ACT is 0 (none) or 1 (gelu_pk)");
    bf16_t* O; int ldc; const float* bias; int split_cols; size_t split_stride; float scale0;
    __device__ __forceinline__ void operator()(const f32x4 (&acc)[2][2][4][2], const Unit& u, int wr, int wc, int fr, int fq) const {
        const int row0 = u.pm * BM + wr * 64 + fr; int colt = u.pn * BM; bf16_t* base = O;
        float sc = 1.f; if (split_cols) { const int t = colt / split_cols; base += (size_t)t * split_stride; colt -= t * split_cols; if (t == 0) sc = scale0; }
        const int col0 = colt + wc * 32 + 8 * fq, bcol0 = u.pn * BM + wc * 32 + 8 * fq;
        f32x4 bv[2][2];
#pragma unroll
        for (int bj = 0; bj < 2; ++bj)
#pragma unroll
            for (int n = 0; n < 2; ++n) bv[bj][n] = bias ? *(const f32x4*)(bias + bcol0 + bj * HALF + 4 * n) : (f32x4){0.f, 0.f, 0.f, 0.f};
#pragma unroll
        for (int ai = 0; ai < 2; ++ai)
#pragma unroll
            for (int m = 0; m < 4; ++m) { bf16_t* rowp = base + (size_t)(row0 + ai * HALF + m * 16) * ldc + col0;
#pragma unroll
                for (int bj = 0; bj < 2; ++bj) { f32x4 v0 = acc[ai][bj][m][0] + bv[bj][0], v1 = acc[ai][bj][m][1] + bv[bj][1];
                    if (ACT == 1) { f32x2 a = gelu_pk((f32x2){v0[0], v0[1]}), b = gelu_pk((f32x2){v0[2], v0[3]}), c = gelu_pk((f32x2){v1[0], v1[1]}), d = gelu_pk((f32x2){v1[2], v1[3]});
                        v0 = (f32x4){a.x, a.y, b.x, b.y}; v1 = (f32x4){c.x, c.y, d.x, d.y}; }
                    v0 = v0 * sc; v1 = v1 * sc; u32x4 w; w.x = cvt_pk_bf16(v0[0], v0[1]); w.y = cvt_pk_bf16(v0[2], v0[3]); w.z = cvt_pk_bf16(v1[0], v1[1]); w.w = cvt_pk_bf16(v1[2], v1[3]);
                    *(u32x4*)(rowp + bj * HALF) = w; } }
    }
};

template <class Epi, class Sched, bool ALIGN_EPI = false, bool SP2 = false>
__device__ __forceinline__ void gemm_phase(PG8_LAS unsigned char* lds, const Gemm g, const Sched& S, const Epi& E) {
    int tid_ = threadIdx.x; asm volatile("" : "+v"(tid_));
    const int tid = tid_, wid = __builtin_amdgcn_readfirstlane(tid >> 6), lane = tid & 63, wr = wid >> 2, wc = wid & 3, fr = lane & 15, fq = lane >> 4;
    const int K = g.K, nt = K / BK;
    unsigned voffA, voffB;
    { int R, C; stage_rc(tid * 16, R, C); const int Rb = Epi::PERM ? ((R & ~31) + perm32(R & 31)) : R; const int Ra = Epi::ROWPERM ? (8 * (R & 15) + ((R >> 4) & 3)) : R;
        voffA = (unsigned)(Ra * K + C) * 2u; voffB = (unsigned)tid * 16u; (void)Rb; }
    const size_t rstepB = 8192, rstepA = Epi::ROWPERM ? (size_t)128 * K * 2 : (size_t)64 * K * 2;
    const size_t kstep = (size_t)(BK * 2);
    const size_t hstep = (size_t)HALF * K * 2; const size_t hstepA = Epi::ROWPERM ? (size_t)4 * K * 2 : hstep;
    const size_t tstep = 2 * hstep;
    const size_t hstepB = 16384, kstepB = 32768, tstepB = (size_t)nt * 32768;
    const unsigned ldsw = (unsigned)wid * 1024u;
    const int aoff = lds_byte(wr * 64 + fr, fq * 8), boff = lds_byte(wc * 32 + fr, fq * 8);
#define PG8_SA(b, h) (((b) * 2 + (h)) * HTB)
#define PG8_SB(b, h) ((4 + (b) * 2 + (h)) * HTB)
#define PG8_STAGE(bufoff, gbase, voff, rstep64) do { _Pragma("unroll") for (int _i = 0; _i < 2; ++_i) \
        __builtin_amdgcn_global_load_lds((const unsigned*)((const char*)(gbase) + (size_t)_i * rstep64 + (voff)), (PG8_LAS unsigned*)(lds + (bufoff) + ldsw + _i * 8192), 16, 0, 0); } while (0)
#define PG8_LDA(dst, b, h) do { _Pragma("unroll") for (int m = 0; m < 4; ++m) _Pragma("unroll") for (int k = 0; k < 2; ++k) dst[m][k] = *(const PG8_LAS bf16x8*)(lds + PG8_SA(b, h) + aoff + m * 2048 + k * 1024); } while (0)
#define PG8_LDB(dst, b, h) do { _Pragma("unroll") for (int n = 0; n < 2; ++n) _Pragma("unroll") for (int k = 0; k < 2; ++k) dst[n][k] = *(const PG8_LAS bf16x8*)(lds + PG8_SB(b, h) + boff + n * 2048 + k * 1024); } while (0)
#define PG8_MMA(ai, bj, At, Bt) do { __builtin_amdgcn_s_setprio(1); _Pragma("unroll") for (int m = 0; m < 4; ++m) _Pragma("unroll") for (int n = 0; n < 2; ++n) _Pragma("unroll") for (int k = 0; k < 2; ++k) \
        acc[ai][bj][m][n] = __builtin_amdgcn_mfma_f32_16x16x32_bf16(Bt[n][k], At[m][k], acc[ai][bj][m][n], 0, 0, 0); __builtin_amdgcn_s_setprio(0); } while (0)
#define PG8_WAIT_V(n) asm volatile("s_waitcnt vmcnt(" #n ")" ::: "memory")
#define PG8_WAIT_L(n) asm volatile("s_waitcnt lgkmcnt(" #n ")" ::: "memory")
#define PG8_BAR __builtin_amdgcn_s_barrier()
#define PG8_SCHED __builtin_amdgcn_sched_barrier(0)
    Unit cur, nxt; int ui = 0;
    if (!S.next(0, cur)) return;
    f32x4 acc[2][2][4][2];
#pragma unroll
    for (int a = 0; a < 2; ++a)
#pragma unroll
        for (int b = 0; b < 2; ++b)
#pragma unroll
            for (int m = 0; m < 4; ++m)
#pragma unroll
                for (int n = 0; n < 2; ++n) acc[a][b][m][n] = (f32x4){0.f, 0.f, 0.f, 0.f};
    bf16x8 At[4][2], B0[2][2], B1[2][2];
    const char* cA = (const char*)g.A + (size_t)cur.pm * tstep; const char* cB = (const char*)g.Bt + (size_t)cur.pn * tstepB;
    S.a_ready(cur);
    if constexpr (SP2) {
        PG8_STAGE(PG8_SB(0, 0), cB, voffB, rstepB); PG8_STAGE(PG8_SB(0, 1), cB + hstepB, voffB, rstepB); PG8_STAGE(PG8_SA(0, 0), cA, voffA, rstepA); PG8_STAGE(PG8_SA(0, 1), cA + hstepA, voffA, rstepA);
        if (wr == 1) PG8_BAR;
        PG8_WAIT_V(2); PG8_BAR;
        PG8_STAGE(PG8_SB(1, 0), cB + kstepB, voffB, rstepB); PG8_STAGE(PG8_SA(1, 0), cA + kstep, voffA, rstepA); PG8_STAGE(PG8_SB(1, 1), cB + hstepB + kstepB, voffB, rstepB);
        PG8_WAIT_V(6); PG8_BAR;
    } else {
        PG8_STAGE(PG8_SB(0, 0), cB, voffB, rstepB); PG8_STAGE(PG8_SA(0, 0), cA, voffA, rstepA); PG8_STAGE(PG8_SB(0, 1), cB + hstepB, voffB, rstepB); PG8_STAGE(PG8_SA(0, 1), cA + hstepA, voffA, rstepA);
        if (wr == 1) PG8_BAR;
        PG8_WAIT_V(4); PG8_BAR;
        PG8_STAGE(PG8_SB(1, 0), cB + kstepB, voffB, rstepB); PG8_STAGE(PG8_SA(1, 0), cA + kstep, voffA, rstepA); PG8_STAGE(PG8_SB(1, 1), cB + hstepB + kstepB, voffB, rstepB);
        PG8_WAIT_V(6); PG8_BAR;
    }
    for (;;) {
        const bool has_next = S.next(ui + 1, nxt);
        const char* nA = has_next ? (const char*)g.A + (size_t)nxt.pm * tstep : cA; const char* nB = has_next ? (const char*)g.Bt + (size_t)nxt.pn * tstepB : cB;
        for (int t = 0; t < nt; t += 2) {
            const bool last = (t == nt - 2);
            const char* a1 = cA + (size_t)(t + 1) * kstep;
            const char* a2 = last ? nA : cA + (size_t)(t + 2) * kstep; const char* b2 = last ? nB : cB + (size_t)(t + 2) * kstepB;
            const char* a3 = a2 + kstep; const char* b3 = b2 + kstepB;
            if (last && has_next) S.a_ready(nxt);
            if constexpr (SP2) {
            PG8_LDB(B0, 0, 0); PG8_LDB(B1, 0, 1); PG8_SCHED; PG8_LDA(At, 0, 0); PG8_STAGE(PG8_SA(1, 1), a1 + hstepA, voffA, rstepA);
            PG8_WAIT_V(8); PG8_WAIT_L(0); PG8_BAR; PG8_MMA(0, 0, At, B0); PG8_MMA(0, 1, At, B1); PG8_BAR; PG8_SCHED;
            PG8_LDA(At, 0, 1); PG8_STAGE(PG8_SB(0, 0), b2, voffB, rstepB); PG8_STAGE(PG8_SB(0, 1), b2 + hstepB, voffB, rstepB); PG8_STAGE(PG8_SA(0, 0), a2, voffA, rstepA);
            PG8_WAIT_V(8); PG8_WAIT_L(0); PG8_BAR; PG8_MMA(1, 0, At, B0); PG8_MMA(1, 1, At, B1); PG8_BAR; PG8_SCHED;
            PG8_LDB(B0, 1, 0); PG8_LDB(B1, 1, 1); PG8_SCHED; PG8_LDA(At, 1, 0); PG8_STAGE(PG8_SA(0, 1), a2 + hstepA, voffA, rstepA);
            PG8_WAIT_V(8); PG8_WAIT_L(0); PG8_BAR; PG8_MMA(0, 0, At, B0); PG8_MMA(0, 1, At, B1); PG8_BAR; PG8_SCHED;
            PG8_LDA(At, 1, 1); PG8_STAGE(PG8_SB(1, 0), b3, voffB, rstepB); PG8_STAGE(PG8_SB(1, 1), b3 + hstepB, voffB, rstepB); PG8_STAGE(PG8_SA(1, 0), a3, voffA, rstepA);
            PG8_WAIT_V(8); PG8_WAIT_L(0); PG8_BAR; PG8_MMA(1, 0, At, B0); PG8_MMA(1, 1, At, B1); PG8_BAR; PG8_SCHED;
            } else {
            PG8_LDB(B0, 0, 0); PG8_SCHED; PG8_LDA(At, 0, 0); PG8_STAGE(PG8_SA(1, 1), a1 + hstepA, voffA, rstepA);
            PG8_WAIT_L(8); PG8_BAR; PG8_WAIT_L(0); PG8_MMA(0, 0, At, B0); PG8_BAR; PG8_SCHED;
            PG8_LDB(B1, 0, 1); PG8_STAGE(PG8_SB(0, 0), b2, voffB, rstepB);
            PG8_BAR; PG8_WAIT_L(0); PG8_MMA(0, 1, At, B1); PG8_BAR;
            PG8_LDA(At, 0, 1); PG8_STAGE(PG8_SA(0, 0), a2, voffA, rstepA);
            PG8_BAR; PG8_WAIT_L(0); PG8_MMA(1, 0, At, B0); PG8_BAR; PG8_SCHED;
            PG8_STAGE(PG8_SB(0, 1), b2 + hstepB, voffB, rstepB);
            PG8_WAIT_V(6); PG8_BAR; PG8_MMA(1, 1, At, B1); PG8_BAR;
            PG8_LDB(B0, 1, 0); PG8_SCHED; PG8_LDA(At, 1, 0); PG8_STAGE(PG8_SA(0, 1), a2 + hstepA, voffA, rstepA);
            PG8_WAIT_L(8); PG8_BAR; PG8_WAIT_L(0); PG8_MMA(0, 0, At, B0); PG8_BAR; PG8_SCHED;
            PG8_LDB(B1, 1, 1); PG8_STAGE(PG8_SB(1, 0), b3, voffB, rstepB);
            PG8_BAR; PG8_WAIT_L(0); PG8_MMA(0, 1, At, B1); PG8_BAR;
            PG8_LDA(At, 1, 1); PG8_STAGE(PG8_SA(1, 0), a3, voffA, rstepA);
            PG8_BAR; PG8_WAIT_L(0); PG8_MMA(1, 0, At, B0); PG8_BAR; PG8_SCHED;
            PG8_STAGE(PG8_SB(1, 1), b3 + hstepB, voffB, rstepB);
            PG8_WAIT_V(6); PG8_BAR; PG8_MMA(1, 1, At, B1); PG8_BAR;
            }
        }
        if constexpr (ALIGN_EPI) { if (wr == 0) PG8_BAR; }
        if constexpr (!Epi::AFTER_DRAIN) { E(acc, cur, wr, wc, fr, fq); S.done(cur); }
        if (!has_next) break;
#pragma unroll
        for (int a = 0; a < 2; ++a)
#pragma unroll
            for (int b = 0; b < 2; ++b)
#pragma unroll
                for (int m = 0; m < 4; ++m)
#pragma unroll
                    for (int n = 0; n < 2; ++n) acc[a][b][m][n] = (f32x4){0.f, 0.f, 0.f, 0.f};
        cur = nxt; cA = nA; cB = nB; ++ui;
        if constexpr (ALIGN_EPI) { if (wr == 1) PG8_BAR; }
    }
    PG8_WAIT_V(0);
    if constexpr (!ALIGN_EPI) { if (wr == 0) PG8_BAR; }
    PG8_BAR;
    if constexpr (Epi::AFTER_DRAIN) { E.fused(acc, cur, wr, wc, fr, fq, lds, wid, lane); S.done(cur); }
#undef PG8_SA
#undef PG8_SB
#undef PG8_STAGE
#undef PG8_LDA
#undef PG8_LDB
#undef PG8_MMA
#undef PG8_WAIT_V
#undef PG8_WAIT_L
#undef PG8_BAR
#undef PG8_SCHED
}
}

#ifndef PG8_SP2
#define PG8_SP2 true
#endif
#ifndef PG8_ALIGN
#define PG8_ALIGN true
#endif
#include <hip/hip_bf16.h>
#include <cmath>
namespace attn_body {
using bf16=__hip_bfloat16;
using bf16x8=__attribute__((ext_vector_type(8)))short;
using s16x4=__attribute__((ext_vector_type(4)))short;
using f32x16=__attribute__((ext_vector_type(16)))float;
using u32x4=__attribute__((ext_vector_type(4)))unsigned;
constexpr int D=64;
constexpr int NW=8,QBLK=32,QB=QBLK*NW,KVBLK=64;
__device__ __forceinline__ int crow(int r,int hi){return (r&3)+8*(r>>2)+4*hi;}
#define SBAR() __builtin_amdgcn_sched_barrier(0)
__device__ __forceinline__ void cmask(f32x16&p0,f32x16&p1,int jb,int qrel,int hi){
  const float NEG=-INFINITY; int kb=64*jb+4*hi;
  #pragma unroll
  for(int r=0;r<16;++r){int kv=kb+(r&3)+8*(r>>2); if(kv>qrel)p0[r]=NEG; if(kv+32>qrel)p1[r]=NEG;}
}

constexpr int NSLOT=3, SLOTB=8192;
constexpr int LDS_K=0, LDS_V=NSLOT*SLOTB, LDS_WS=2*NSLOT*SLOTB, LDS_OST=LDS_WS+NW*64*4, LDS_BYTES=LDS_OST+NW*4096;
constexpr float C2=0.125f*1.4426950408889634f;
__device__ __forceinline__ void glds16(const void*gsrc,unsigned lds_dst){unsigned keep;
  asm volatile("s_mov_b32 %0, m0\n\ts_mov_b32 m0, %2\n\ts_nop 0\n\tglobal_load_lds_dwordx4 %1, off\n\ts_mov_b32 m0, %0":"=&s"(keep):"v"(gsrc),"s"(lds_dst):"memory");}
__device__ __forceinline__ float max3f(float a,float b,float c){float r;asm("v_max3_f32 %0, %1, %2, %3":"=v"(r):"v"(a),"v"(b),"v"(c));return r;}
__device__ __forceinline__ float max2f(float a,float b){float r;asm("v_max_f32_e32 %0, %1, %2":"=v"(r):"v"(a),"v"(b));return r;}
__device__ __forceinline__ float fadd_s(float a,float b){float r;asm("v_add_f32_e32 %0, %1, %2":"=v"(r):"v"(a),"v"(b));return r;}
__device__ __forceinline__ float fsub_s(float a,float b){float r;asm("v_sub_f32_e32 %0, %1, %2":"=v"(r):"v"(a),"v"(b));return r;}
typedef float f32x2_t __attribute__((ext_vector_type(2))); typedef __bf16 bf16x2_t __attribute__((ext_vector_type(2)));
__device__ __forceinline__ unsigned cvtpk_s(float lo,float hi){f32x2_t v={lo,hi};bf16x2_t b=__builtin_convertvector(v,bf16x2_t);return __builtin_bit_cast(unsigned,b);}
#define WAIT_BAR(N) asm volatile("s_waitcnt vmcnt(" #N ") lgkmcnt(0)\n\ts_barrier":::"memory")

__device__ __forceinline__ void qkt(f32x16&p0,f32x16&p1,const char*Kslot,const bf16x8*qr,const f32x16&negm,int r32,int hi){
  const char*kb=Kslot+hi*1024+r32*16;
  #pragma unroll
  for(int d0=0;d0<4;++d0){
    const bf16x8 b0=*reinterpret_cast<const bf16x8*>(kb+d0*2048);
    const bf16x8 b1=*reinterpret_cast<const bf16x8*>(kb+d0*2048+512);
    if(d0==0){p0=__builtin_amdgcn_mfma_f32_32x32x16_bf16(b0,qr[0],negm,0,0,0);p1=__builtin_amdgcn_mfma_f32_32x32x16_bf16(b1,qr[0],negm,0,0,0);}
    else{p0=__builtin_amdgcn_mfma_f32_32x32x16_bf16(b0,qr[d0],p0,0,0,0);p1=__builtin_amdgcn_mfma_f32_32x32x16_bf16(b1,qr[d0],p1,0,0,0);}}
}
typedef __attribute__((address_space(3))) const char* lds_cptr;
typedef short v4i16_t __attribute__((ext_vector_type(4)));
__device__ __forceinline__ void kload8(bf16x8*kf,lds_cptr kp){
  kf[0]=*(const __attribute__((address_space(3))) bf16x8*)(kp);      kf[1]=*(const __attribute__((address_space(3))) bf16x8*)(kp+512);
  kf[2]=*(const __attribute__((address_space(3))) bf16x8*)(kp+2048); kf[3]=*(const __attribute__((address_space(3))) bf16x8*)(kp+2560);
  kf[4]=*(const __attribute__((address_space(3))) bf16x8*)(kp+4096); kf[5]=*(const __attribute__((address_space(3))) bf16x8*)(kp+4608);
  kf[6]=*(const __attribute__((address_space(3))) bf16x8*)(kp+6144); kf[7]=*(const __attribute__((address_space(3))) bf16x8*)(kp+6656);
}
__device__ __forceinline__ void kload2(bf16x8*kf,lds_cptr kp,int j){ kf[2*j]=*(const __attribute__((address_space(3))) bf16x8*)(kp+j*2048); kf[2*j+1]=*(const __attribute__((address_space(3))) bf16x8*)(kp+j*2048+512); }
__device__ __forceinline__ s16x4 vtr(lds_cptr p){ return __builtin_bit_cast(s16x4,__builtin_amdgcn_ds_read_tr16_b64_v4i16((__attribute__((address_space(3))) v4i16_t*)p)); }
__device__ __forceinline__ float rowmax(const f32x16&p0,const f32x16&p1){
  float a=max3f(p0[0],p0[1],p1[0]),b=max3f(p0[2],p0[3],p1[1]);a=max3f(a,p1[2],p1[3]);
  #pragma unroll
  for(int r=4;r<16;r+=4){a=max3f(a,p0[r],p0[r+1]);b=max3f(b,p0[r+2],p0[r+3]);a=max3f(a,p1[r],p1[r+1]);b=max3f(b,p1[r+2],p1[r+3]);}
  const float m=max2f(a,b);
  auto rr=__builtin_amdgcn_permlane32_swap(__float_as_uint(m),__float_as_uint(m),false,false);
  return max2f(__uint_as_float(rr[0]),__uint_as_float(rr[1]));
}
__device__ __forceinline__ void pv(f32x16*o,int vb,bf16x8 pa0,bf16x8 pa1,bf16x8 pa2,bf16x8 pa3){
  #pragma unroll
  for(int d0=0;d0<2;++d0){s16x4 lo[4],hi[4];
    #pragma unroll
    for(int ks=0;ks<4;++ks){
      asm volatile("ds_read_b64_tr_b16 %0,%1 offset:%c2":"=&v"(lo[ks]):"v"(vb),"i"(d0*4096+ks*1024):"memory");
      asm volatile("ds_read_b64_tr_b16 %0,%1 offset:%c2":"=&v"(hi[ks]):"v"(vb),"i"(d0*4096+ks*1024+512):"memory");}
    asm volatile("s_waitcnt lgkmcnt(0)":::"memory");SBAR();
    #define PK(k) (bf16x8){lo[k][0],lo[k][1],lo[k][2],lo[k][3],hi[k][0],hi[k][1],hi[k][2],hi[k][3]}
    o[d0]=__builtin_amdgcn_mfma_f32_32x32x16_bf16(pa0,PK(0),o[d0],0,0,0);
    o[d0]=__builtin_amdgcn_mfma_f32_32x32x16_bf16(pa1,PK(1),o[d0],0,0,0);
    o[d0]=__builtin_amdgcn_mfma_f32_32x32x16_bf16(pa2,PK(2),o[d0],0,0,0);
    o[d0]=__builtin_amdgcn_mfma_f32_32x32x16_bf16(pa3,PK(3),o[d0],0,0,0);
    #undef PK
  }
}

#ifndef ATTN_STORE16
#define ATTN_STORE16(p,v) (*(u32x4*)(p)=(v))
#endif
template<int THRL,bool STATIC> __device__ __forceinline__ void attn_unit(const bf16*Qu,const int QP,const bf16*__restrict__ Kh,const bf16*__restrict__ Vh,const int KP,const int NT,bf16*Ou,const int OP,char*shm,const float mstat){
  int tid_=threadIdx.x; asm volatile("":"+v"(tid_));
  const int tid=tid_,lane=tid&63,r32=lane&31,hi=lane>>5; const int wid=__builtin_amdgcn_readfirstlane(tid>>6);
  const bf16*Qw=Qu+(long)(wid*QBLK)*QP;
  const unsigned lds0=(unsigned)(uintptr_t)shm;
  float*wsf=(float*)(shm+LDS_WS)+wid*64;
  const bf16*ksrc=Kh+wid*512+lane*8;
  const bf16*vsrc=Vh+wid*512+lane*8; (void)KP;
  const unsigned kdst=lds0+LDS_K+wid*1024, vdst=lds0+LDS_V+wid*1024;
  #define DMA_K(t,slot) glds16(ksrc+(long)(t)*4096,(unsigned)__builtin_amdgcn_readfirstlane(kdst+(slot)))
  #define DMA_V(t,slot) glds16(vsrc+(long)(t)*4096,(unsigned)__builtin_amdgcn_readfirstlane(vdst+(slot)))
  const int vb0=(int)(lds0+LDS_V)+((lane>>4)&1)*32+(lane&3)*8+(4*hi+((lane&15)>>2))*64;
  const char*Kbase=shm+LDS_K; bf16x8 kf[8];
  const lds_cptr shm3=(lds_cptr)shm; const lds_cptr kp0=shm3+LDS_K+hi*1024+r32*16; const lds_cptr vp0=shm3+LDS_V+((lane>>4)&1)*32+(lane&3)*8+(4*hi+((lane&15)>>2))*64;
  DMA_K(0,0);DMA_V(0,0);DMA_K(1,SLOTB);
  bf16x8 qr[4];
  #pragma unroll
  for(int d0=0;d0<4;++d0)qr[d0]=*reinterpret_cast<const bf16x8*>(&Qw[(long)r32*QP+d0*16+hi*8]);
  float mhat=0.f,l_reg=0.f;f32x16 o[2];o[0]=f32x16{};o[1]=f32x16{};f32x16 negm=f32x16{};asm volatile("":"+v"(negm));
  #define CMASK(P0,P1,t) do{}while(0)
  bool resc=false;
  #define START(P0,P1) do{ float rm; if constexpr(STATIC){rm=mstat;}else{rm=rowmax(P0,P1);} resc=false; \
    { const float dl=rm; mhat=fadd_s(mhat,dl); \
      _Pragma("unroll") for(int r=0;r<16;++r){P0[r]=fsub_s(P0[r],dl);P1[r]=fsub_s(P1[r],dl);} \
      _Pragma("unroll") for(int r=0;r<16;++r)negm[r]=-mhat; asm volatile("":"+v"(negm)); } \
    _Pragma("unroll") for(int r=0;r<16;++r)P0[r]=__builtin_amdgcn_exp2f(P0[r]); }while(0)
  #define RESC() do{ if(resc){ asm volatile("s_waitcnt lgkmcnt(0)":::"memory"); \
      _Pragma("unroll") for(int d_=0;d_<2;++d_) _Pragma("unroll") for(int r=0;r<16;++r)o[d_][r]*=wsf[crow(r,hi)]; } }while(0)
  f32x16 pA0,pA1,pB0,pB1;
  int sl_prev=0,sl_cur=0,sl_next=SLOTB;
  #define ROT() do{sl_prev=sl_cur;sl_cur=sl_next;sl_next=(sl_next==(NSLOT-1)*SLOTB)?0:sl_next+SLOTB;}while(0)
  DMA_K(2,2*SLOTB);
  WAIT_BAR(3);
  qkt(pA0,pA1,Kbase,qr,negm,r32,hi);asm volatile("s_nop 15\n\ts_nop 7":"+v"(pA0),"+v"(pA1));CMASK(pA0,pA1,0);
  START(pA0,pA1);
  _Pragma("unroll") for(int r=0;r<16;++r)pA1[r]=__builtin_amdgcn_exp2f(pA1[r]);
  WAIT_BAR(0);
  DMA_K(3,0);DMA_V(1,SLOTB);
  ROT();
  kload8(kf,kp0+sl_cur);
  WAIT_BAR(2);
  s16x4 vlo[8],vhi[8]; u32x4 pw0,pw1,pw2,pw3;
  #define PKW(P,B) cvtpk_s(P[B],P[B+1])
  #define PAF(k) __builtin_bit_cast(bf16x8,pw##k)
  #define VFR(i) (bf16x8){vlo[i][0],vlo[i][1],vlo[i][2],vlo[i][3],vhi[i][0],vhi[i][1],vhi[i][2],vhi[i][3]}
  #define PIN(x) asm volatile("":"+v"(x))
  #define MX3(a,b,c) __builtin_fmaxf(__builtin_fmaxf((a),(b)),(c))
  #define GAPA(MF,A0,A1,A2,A3,W0,W1,PW) do{ MF; sacc+=A0; sacc+=A1; sacc+=A2; sacc+=A3; PIN(sacc); W0; W1; PIN(PW); SBAR(); }while(0)
  #define EX(v) __builtin_amdgcn_exp2f(v)
  #define GAPB(MF,X,B) do{ MF; X[B]=EX(X[B]); X[B+1]=EX(X[B+1]); X[B+2]=EX(X[B+2]); X[B+3]=EX(X[B+3]); PIN(X); SBAR(); }while(0)
  #define VRD(i) do{ vlo[i]=vtr(vp_+(((i)>>2)*4096+((i)&3)*1024)); vhi[i]=vtr(vp_+(((i)>>2)*4096+((i)&3)*1024+512)); }while(0)
  #define KRD(G,j) do{ if(G){ kload2(kf,kp0+sl_next,j); SBAR(); } }while(0)
  #define STEP(C0,C1,P0,P1,t,GK,GV,GL) do{ SBAR(); \
    const lds_cptr vp_=vp0+sl_prev; \
    VRD(0); SBAR(); float sacc=(P0[0]+P0[1]); \
    GAPA(C0=__builtin_amdgcn_mfma_f32_32x32x16_bf16(kf[0],qr[0],negm,0,0,0), P0[2],P0[3],P0[4],P0[5],     pw0[0]=PKW(P0,0), pw0[1]=PKW(P0,2), pw0); \
    VRD(4); SBAR(); GAPA(C1=__builtin_amdgcn_mfma_f32_32x32x16_bf16(kf[1],qr[0],negm,0,0,0), P0[6],P0[7],P0[8],P0[9],     pw0[2]=PKW(P0,4), pw0[3]=PKW(P0,6), pw0); \
    VRD(1); SBAR(); GAPA(C0=__builtin_amdgcn_mfma_f32_32x32x16_bf16(kf[2],qr[1],C0,0,0,0),   P0[10],P0[11],P0[12],P0[13], pw1[0]=PKW(P0,8), pw1[1]=PKW(P0,10), pw1); \
    VRD(5); SBAR(); GAPA(C1=__builtin_amdgcn_mfma_f32_32x32x16_bf16(kf[3],qr[1],C1,0,0,0),   P0[14],P0[15],P1[0],P1[1],   pw1[2]=PKW(P0,12),pw1[3]=PKW(P0,14), pw1); \
    VRD(2); SBAR(); GAPA(C0=__builtin_amdgcn_mfma_f32_32x32x16_bf16(kf[4],qr[2],C0,0,0,0),   P1[2],P1[3],P1[4],P1[5],     pw2[0]=PKW(P1,0), pw2[1]=PKW(P1,2), pw2); \
    VRD(6); SBAR(); GAPA(C1=__builtin_amdgcn_mfma_f32_32x32x16_bf16(kf[5],qr[2],C1,0,0,0),   P1[6],P1[7],P1[8],P1[9],     pw2[2]=PKW(P1,4), pw2[3]=PKW(P1,6), pw2); \
    VRD(3); SBAR(); GAPA(C0=__builtin_amdgcn_mfma_f32_32x32x16_bf16(kf[6],qr[3],C0,0,0,0),   P1[10],P1[11],P1[12],P1[13], pw3[0]=PKW(P1,8), pw3[1]=PKW(P1,10), pw3); \
    VRD(7); SBAR(); GAPA(C1=__builtin_amdgcn_mfma_f32_32x32x16_bf16(kf[7],qr[3],C1,0,0,0),   P1[14],P1[15],0.f,0.f,       pw3[2]=PKW(P1,12),pw3[3]=PKW(P1,14), pw3); \
    l_reg+=sacc; \
    if(GK){DMA_K((t)+3,sl_cur);} if(GV){DMA_V((t)+1,sl_next);} \
    CMASK(C0,C1,t); \
    if constexpr(!STATIC){ float a=MX3(C0[0],C0[1],C1[0]),b=MX3(C0[2],C0[3],C1[1]); a=MX3(a,C1[2],C1[3]); \
      _Pragma("unroll") for(int r=4;r<16;r+=4){a=MX3(a,C0[r],C0[r+1]);b=MX3(b,C0[r+2],C0[r+3]);a=MX3(a,C1[r],C1[r+1]);b=MX3(b,C1[r+2],C1[r+3]);} \
      float rm=__builtin_fmaxf(a,b); { auto rr=__builtin_amdgcn_permlane32_swap(__float_as_uint(rm),__float_as_uint(rm),false,false); rm=__builtin_fmaxf(__uint_as_float(rr[0]),__uint_as_float(rr[1])); } \
      resc=false; \
      if(__builtin_expect(__any(rm>(float)THRL),0)){ const float dl=__builtin_fmaxf(rm,0.f); mhat+=dl; \
        _Pragma("unroll") for(int r=0;r<16;++r){C0[r]-=dl;C1[r]-=dl;} \
        _Pragma("unroll") for(int r=0;r<16;++r)negm[r]=-mhat; asm volatile("":"+v"(negm)); \
        const float f=__builtin_amdgcn_exp2f(-dl); l_reg*=f; if(hi==0)wsf[r32]=f; resc=true; } } \
    SBAR(); \
    GAPB(o[0]=__builtin_amdgcn_mfma_f32_32x32x16_bf16(PAF(0),VFR(0),o[0],0,0,0), C0,0); \
    GAPB(o[1]=__builtin_amdgcn_mfma_f32_32x32x16_bf16(PAF(0),VFR(4),o[1],0,0,0), C0,4); \
    KRD(GL,0); GAPB(o[0]=__builtin_amdgcn_mfma_f32_32x32x16_bf16(PAF(1),VFR(1),o[0],0,0,0), C0,8); \
    KRD(GL,1); GAPB(o[1]=__builtin_amdgcn_mfma_f32_32x32x16_bf16(PAF(1),VFR(5),o[1],0,0,0), C0,12); \
    KRD(GL,2); GAPB(o[0]=__builtin_amdgcn_mfma_f32_32x32x16_bf16(PAF(2),VFR(2),o[0],0,0,0), C1,0); \
    KRD(GL,3); GAPB(o[1]=__builtin_amdgcn_mfma_f32_32x32x16_bf16(PAF(2),VFR(6),o[1],0,0,0), C1,4); \
    GAPB(o[0]=__builtin_amdgcn_mfma_f32_32x32x16_bf16(PAF(3),VFR(3),o[0],0,0,0), C1,8); \
    GAPB(o[1]=__builtin_amdgcn_mfma_f32_32x32x16_bf16(PAF(3),VFR(7),o[1],0,0,0), C1,12); \
    }while(0)
  int t=1;
  #undef CMASK
  #define CMASK(P0,P1,t) do{}while(0)
  for(;t+5<NT;t+=2){
    STEP(pB0,pB1,pA0,pA1,t,true,true,true);     WAIT_BAR(2); RESC(); ROT();
    STEP(pA0,pA1,pB0,pB1,t+1,true,true,true);   WAIT_BAR(2); RESC(); ROT();
  }
  #undef CMASK
  #define CMASK(P0,P1,t) do{}while(0)
  #define ENDW(tt) do{ if((tt)+3<NT){WAIT_BAR(2);} else if((tt)+2<NT){WAIT_BAR(1);} else {WAIT_BAR(0);} }while(0)
  for(;t+1<NT;t+=2){
    STEP(pB0,pB1,pA0,pA1,t,(t+3<NT),(t+1<NT),(t+1<NT));       ENDW(t);   RESC(); ROT();
    STEP(pA0,pA1,pB0,pB1,t+1,(t+4<NT),(t+2<NT),(t+2<NT));     ENDW(t+1); RESC(); ROT();
  }
  STEP(pB0,pB1,pA0,pA1,NT-1,false,false,false); RESC();
  { float sacc=pB0[0]+pB0[1]; _Pragma("unroll") for(int r=2;r<16;++r)sacc+=pB0[r]; _Pragma("unroll") for(int r=0;r<16;++r)sacc+=pB1[r]; l_reg+=sacc;
    pw0=(u32x4){PKW(pB0,0),PKW(pB0,2),PKW(pB0,4),PKW(pB0,6)};pw1=(u32x4){PKW(pB0,8),PKW(pB0,10),PKW(pB0,12),PKW(pB0,14)};pw2=(u32x4){PKW(pB1,0),PKW(pB1,2),PKW(pB1,4),PKW(pB1,6)};pw3=(u32x4){PKW(pB1,8),PKW(pB1,10),PKW(pB1,12),PKW(pB1,14)};
    SBAR(); pv(o,vb0+sl_cur,PAF(0),PAF(1),PAF(2),PAF(3)); }
  #undef PKW
  #undef PAF
  #undef VFR
  #undef PIN
  #undef MX3
  #undef GAPA
  #undef GAPB
  #undef EX
  #undef VRD
  #undef KRD
  #undef STEP
  #undef ENDW
  {auto rr=__builtin_amdgcn_permlane32_swap(__float_as_uint(l_reg),__float_as_uint(l_reg),false,false);l_reg=__uint_as_float(rr[0])+__uint_as_float(rr[1]);}
  if(hi==0)wsf[32+r32]=l_reg;asm volatile("s_waitcnt lgkmcnt(0)":::"memory");
  float rli[16];
  #pragma unroll
  for(int r=0;r<16;++r)rli[r]=__builtin_amdgcn_rcpf(wsf[32+crow(r,hi)]);
  bf16*Ow=Ou+(long)(wid*QBLK)*OP;
  { bf16*stg=(bf16*)(shm+LDS_OST)+wid*2048;
    #pragma unroll
    for(int r=0;r<16;++r){const int orow=crow(r,hi);
      #pragma unroll
      for(int d0=0;d0<2;++d0)stg[orow*64+d0*32+r32]=__float2bfloat16(o[d0][r]*rli[r]);}
    asm volatile("s_waitcnt lgkmcnt(0)":::"memory");
    #pragma unroll
    for(int i=0;i<4;++i){const int row=i*8+(lane>>3),ch=lane&7; const u32x4 v=*(const u32x4*)(stg+row*64+ch*8); ATTN_STORE16(Ow+(long)row*OP+ch*8,v);} }
  asm volatile("s_waitcnt lgkmcnt(0)\n\ts_barrier":::"memory");
  #undef DMA_K
  #undef DMA_V
  #undef CMASK
  #undef START
  #undef RESC
  #undef ROT
}
constexpr int ATTN_LDS_BYTES=LDS_BYTES;
#undef SBAR
#undef WAIT_BAR
}
#ifndef REP_P0
#define REP_P0 1
#endif
#ifndef REP_PA
#define REP_PA 1
#endif
#ifndef REP_PB
#define REP_PB 1
#endif
#ifndef REP_PC
#define REP_PC 1
#endif
#ifndef REP_PE
#define REP_PE 1
#endif
#ifndef REP_PF
#define REP_PF 1
#endif
#ifndef REP_PG
#define REP_PG 1
#endif

#include <hip/hip_cooperative_groups.h>
namespace cg = cooperative_groups;
#define LAS __attribute__((address_space(3)))
#define GAS_ __attribute__((address_space(1)))
typedef unsigned short bf16;
typedef unsigned v4u __attribute__((ext_vector_type(4)));
typedef unsigned v2u __attribute__((ext_vector_type(2)));
typedef float f32x4 __attribute__((ext_vector_type(4)));
typedef float f32x2 __attribute__((ext_vector_type(2)));
typedef short bf16x8 __attribute__((ext_vector_type(8)));

constexpr int NWAVES = 8, NTHR = 512;
constexpr int DMOD = 1024, NLAT = 16384, NCTXR = 512, MROWS = 16896, SEQL = 8192, CTXL = 256, NLAYER = 4;
constexpr int DIN = 2048, DFF = 2816, DUP = 5632, KVROWS = 8448, NMOD = 6;
constexpr float EPS = 1e-6f;
constexpr float QSCALE = 0.125f * 1.4426950408889634f;

constexpr size_t MiB = 1u << 20;
constexpr size_t WS_MODV = 0;
constexpr size_t WS_BAR = 384 * 1024;
constexpr size_t WS_PTRS = 448 * 1024;
constexpr size_t WS_ROPE = 512 * 1024;
constexpr size_t WS_XSC = 1 * MiB;
constexpr size_t WS_W0 = 4 * MiB, WS_W1 = 258 * MiB, WS_WSTRIDE = 23592960;
constexpr size_t WO_WIN = 0, WO_WOUT = 4 * MiB, WO_WUP = 6 * MiB, WO_WDN = 17 * MiB;
constexpr size_t WS_CNT = 400 * 1024;
constexpr size_t WS_ACT = 28 * MiB;
constexpr size_t WS_Q = 120 * MiB;
constexpr size_t WS_K = WS_Q + (size_t)MROWS * 512 * 2;
constexpr size_t WS_V = WS_K + (size_t)MROWS * 128 * 2;
constexpr size_t WS_U = WS_V + (size_t)MROWS * 128 * 2;
constexpr size_t WS_VN = WS_U + (size_t)MROWS * 256 * 2;
constexpr size_t WS_CB = WS_VN + (size_t)MROWS * 256 * 2;
constexpr size_t WS_CCH = WS_CB + (size_t)MROWS * 256 * 2;
constexpr size_t WS_MIX = WS_CCH + (size_t)MROWS * 256 * 2;
constexpr size_t WS_HALO = 211 * MiB;
constexpr size_t WS_H = 224 * MiB;
constexpr size_t WS_XB = WS_W1 + WS_WSTRIDE;
constexpr size_t WS_END = WS_XB + (size_t)NLAT * 1024 * 2;
static_assert(WS_MIX + (size_t)MROWS * 1024 * 2 <= WS_HALO && WS_HALO + (size_t)(MROWS / 128) * 4 * DUP * 4 <= WS_H && WS_ACT + (size_t)MROWS * DFF * 2 <= WS_Q && WS_W0 + WS_WSTRIDE <= WS_ACT && WO_WDN + (size_t)1024 * DFF * 2 <= WS_WSTRIDE && WS_H + (size_t)MROWS * 1024 * 2 <= WS_W1, "ws map");

constexpr int RING_BYTES = 131072, LDS_BYTES = 147456;

__device__ __forceinline__ unsigned pk2(float lo, float hi) { return pg8::cvt_pk_bf16(lo, hi); }
__device__ __forceinline__ float bf_lo(unsigned w) { return __uint_as_float(w << 16); }
__device__ __forceinline__ float bf_hi(unsigned w) { return __uint_as_float(w & 0xffff0000u); }
__device__ __forceinline__ float sigmoid_f(float x) { return __builtin_amdgcn_rcpf(1.f + __builtin_amdgcn_exp2f(-1.4426950408889634f * x)); }
__device__ __forceinline__ float silu_f(float x) { return x * sigmoid_f(x); }
__device__ __forceinline__ float gelu_t(float x) { const float z = 0.7978845608028654f * (x + 0.044715f * x * x * x); return x * sigmoid_f(2.f * z); }
__device__ __forceinline__ float wave_sum(float v) {
#pragma unroll
    for (int o = 1; o < 64; o <<= 1) v += __shfl_xor(v, o);
    return v;
}

namespace pg8 {
typedef unsigned u32x2 __attribute__((ext_vector_type(2)));
struct EpiResid {
    static constexpr bool PERM = true, AFTER_DRAIN = false, ROWPERM = false;
    const bf16_t* base_lat; bf16_t* out_lat; const float* modv; int gi;
    __device__ __forceinline__ void operator()(const f32x4 (&acc)[2][2][4][2], const Unit& u, int wr, int wc, int fr, int fq) const {
        const int s = u.pm < 32 ? 0 : 1;
        const float* g = modv + (size_t)(s * 6 + gi) * 1024;
        const bf16_t* bp = base_lat + (size_t)u.pm * 256 * 1024; bf16_t* op = out_lat + (size_t)u.pm * 256 * 1024;
        const int col0 = u.pn * 256 + wc * 32 + 8 * fq;
        f32x4 gv[2][2];
#pragma unroll
        for (int bj = 0; bj < 2; ++bj)
#pragma unroll
            for (int n = 0; n < 2; ++n) gv[bj][n] = *(const f32x4*)(g + col0 + bj * 128 + 4 * n);
#pragma unroll
        for (int ai = 0; ai < 2; ++ai) {
        u32x4 b[4][2];
#pragma unroll
            for (int m = 0; m < 4; ++m) { const size_t off = (size_t)(ai * 128 + wr * 64 + m * 16 + fr) * 1024 + col0;
#pragma unroll
                for (int bj = 0; bj < 2; ++bj) b[m][bj] = *(const u32x4*)(bp + off + bj * 128); }
        asm volatile("" ::: "memory");
#pragma unroll
            for (int m = 0; m < 4; ++m) { const size_t off = (size_t)(ai * 128 + wr * 64 + m * 16 + fr) * 1024 + col0;
#pragma unroll
                for (int bj = 0; bj < 2; ++bj) { const u32x4 w = b[m][bj];
                    const f32x4 x0 = (f32x4){__uint_as_float(w.x << 16), __uint_as_float(w.x & 0xffff0000u), __uint_as_float(w.y << 16), __uint_as_float(w.y & 0xffff0000u)} + gv[bj][0] * acc[ai][bj][m][0];
                    const f32x4 x1 = (f32x4){__uint_as_float(w.z << 16), __uint_as_float(w.z & 0xffff0000u), __uint_as_float(w.w << 16), __uint_as_float(w.w & 0xffff0000u)} + gv[bj][1] * acc[ai][bj][m][1];
                    u32x4 o; o.x = cvt_pk_bf16(x0[0], x0[1]); o.y = cvt_pk_bf16(x0[2], x0[3]); o.z = cvt_pk_bf16(x1[0], x1[1]); o.w = cvt_pk_bf16(x1[2], x1[3]);
                    *(u32x4*)(op + off + bj * 128) = o; } }
        asm volatile("" ::: "memory");
        }
    }
};

struct EpiProj {
    static constexpr bool PERM = true, AFTER_DRAIN = false, ROWPERM = false;
    bf16_t *Q, *KB, *VB, *U, *VN, *CB, *CCH;
    const float *qg, *kg; const f32x2* rope;
    __device__ __forceinline__ static void st8(bf16_t* p, const float (&o)[8]) {
        u32x4 w; w.x = cvt_pk_bf16(o[0], o[1]); w.y = cvt_pk_bf16(o[2], o[3]); w.z = cvt_pk_bf16(o[4], o[5]); w.w = cvt_pk_bf16(o[6], o[7]); *(u32x4*)p = w;
    }
    __device__ __forceinline__ void operator()(const f32x4 (&acc)[2][2][4][2], const Unit& u, int wr, int wc, int fr, int fq) const {
        const int pn = u.pn, pm = u.pm;
        const bool isctx = pm >= 64;
        const int kvb = isctx ? (pm - 64) : (pm >> 5), kvr0 = isctx ? 0 : 256 + (pm & 31) * 256;
        const int dof = 8 * fq;
        float gq[2][8];
        const bool qk = (pn == 2 || pn == 3 || (pn == 4 && wc < 2));
        if (qk) { const float* gp = (pn == 4) ? kg : qg;
#pragma unroll
            for (int bj = 0; bj < 2; ++bj)
#pragma unroll
                for (int k = 0; k < 8; ++k) gq[bj][k] = gp[32 * bj + dof + k]; }
#pragma unroll
        for (int ai = 0; ai < 2; ++ai)
#pragma unroll
            for (int m = 0; m < 4; ++m) {
                const int rl = ai * 128 + wr * 64 + m * 16 + fr; const int gm = pm * 256 + rl;
                float v[2][8];
#pragma unroll
                for (int bj = 0; bj < 2; ++bj)
#pragma unroll
                    for (int n = 0; n < 2; ++n)
#pragma unroll
                        for (int i = 0; i < 4; ++i) v[bj][4 * n + i] = acc[ai][bj][m][n][i];
                if (pn == 0) {
#pragma unroll
                    for (int bj = 0; bj < 2; ++bj) { float o[8];
#pragma unroll
                        for (int k = 0; k < 8; ++k) o[k] = gelu_t(v[bj][k]);
                        st8(U + (size_t)gm * 256 + 64 * wc + 32 * bj + dof, o); }
                } else if (pn == 1) {
                    float s = 0.f;
#pragma unroll
                    for (int bj = 0; bj < 2; ++bj)
#pragma unroll
                        for (int k = 0; k < 8; ++k) { v[bj][k] = gelu_t(v[bj][k]); s += v[bj][k]; }
                    s += __shfl_xor(s, 16); s += __shfl_xor(s, 32);
                    const float mean = s * (1.f / 64.f); float q = 0.f;
#pragma unroll
                    for (int bj = 0; bj < 2; ++bj)
#pragma unroll
                        for (int k = 0; k < 8; ++k) { v[bj][k] -= mean; q += v[bj][k] * v[bj][k]; }
                    q += __shfl_xor(q, 16); q += __shfl_xor(q, 32);
                    const float rstd = rsqrtf(q * (1.f / 64.f) + EPS);
#pragma unroll
                    for (int bj = 0; bj < 2; ++bj) { float o[8];
#pragma unroll
                        for (int k = 0; k < 8; ++k) o[k] = v[bj][k] * rstd;
                        st8(VN + (size_t)gm * 256 + 64 * wc + 32 * bj + dof, o); }
                } else if (qk) {
                    float ss = 0.f;
#pragma unroll
                    for (int bj = 0; bj < 2; ++bj)
#pragma unroll
                        for (int k = 0; k < 8; ++k) ss += v[bj][k] * v[bj][k];
                    ss += __shfl_xor(ss, 16); ss += __shfl_xor(ss, 32);
                    const float r = rsqrtf(ss * (1.f / 64.f) + EPS);
                    const int t = gm & (SEQL - 1);
                    const float osc = (pn == 4) ? 1.f : QSCALE;
#pragma unroll
                    for (int bj = 0; bj < 2; ++bj) { float o[8];
                        const int pos = (bj == 0) ? (t >> 6) : (t & 63);
                        const f32x2* rp = rope + pos * 16 + 8 * (fq & 1);
                        f32x4 cs4[4];
                        if (!isctx) {
#pragma unroll
                            for (int k = 0; k < 4; ++k) cs4[k] = ((const f32x4*)rp)[k];
                        }
#pragma unroll
                        for (int k = 0; k < 8; ++k) {
                            float y = v[bj][k] * r * gq[bj][k];
                            if (!isctx) { const float pr = __shfl_xor(y, 32); const float cx = cs4[k >> 1][2 * (k & 1)], sx = cs4[k >> 1][2 * (k & 1) + 1]; y = (fq < 2) ? (y * cx - pr * sx) : (y * cx + pr * sx); }
                            o[k] = y * osc; }
                        if (pn == 4) { const int kvr = kvr0 + rl; st8(KB + ((((size_t)(kvb * 2 + wc) * (KVROWS / 64) + (kvr >> 6)) * 8 + (4 * bj + fq)) * 64 + (kvr & 63)) * 8, o); }
                        else st8(Q + (size_t)gm * 512 + 64 * (4 * (pn - 2) + wc) + 32 * bj + dof, o); }
                } else if (pn == 4) {
#pragma unroll
                    for (int bj = 0; bj < 2; ++bj) { const int kvr = kvr0 + rl; st8(VB + ((((size_t)(kvb * 2 + wc - 2) * (KVROWS / 64) + (kvr >> 6)) * 8 + (4 * bj + ((kvr >> 4) & 3))) * 16 + (kvr & 15)) * 32 + dof, v[bj]); }
                } else if (pn == 5) {
#pragma unroll
                    for (int bj = 0; bj < 2; ++bj) st8(CB + (size_t)gm * 256 + 64 * wc + 32 * bj + dof, v[bj]);
                } else {
                    float o[8];
#pragma unroll
                    for (int k = 0; k < 8; ++k) o[k] = v[0][k] * v[1][k];
                    st8(CCH + (size_t)gm * 256 + 128 * (pn - 6) + 32 * wc + dof, o);
                }
            }
    }
};
struct EpiUpConv {
    static constexpr bool PERM = true, AFTER_DRAIN = false, ROWPERM = true;
    bf16_t* ACT; float* HALO; const float* cw;
    __device__ __forceinline__ void operator()(const f32x4 (&acc)[2][2][4][2], const Unit& u, int wr, int wc, int fr, int fq) const {
        const int rbase = u.pm * 256 + 128 * wr + 8 * fr, seg = u.pm * 2 + wr;
        const int ch0 = 128 * u.pn + 32 * wc + 8 * fq;
        unsigned pk[8][4];
#pragma unroll
        for (int n = 0; n < 2; ++n) {
            const int ch = ch0 + 4 * n;
            const f32x4 wa0 = *(const f32x4*)(cw + ch), wa1 = *(const f32x4*)(cw + DUP + ch), wa2 = *(const f32x4*)(cw + 2 * DUP + ch);
            const f32x4 wg0 = *(const f32x4*)(cw + DFF + ch), wg1 = *(const f32x4*)(cw + DUP + DFF + ch), wg2 = *(const f32x4*)(cw + 2 * DUP + DFF + ch);
            float act[8][4];
#pragma unroll
            for (int i = 0; i < 4; ++i) {
                float a[10], g[10];
#pragma unroll
                for (int ai = 0; ai < 2; ++ai)
#pragma unroll
                    for (int m = 0; m < 4; ++m) { a[1 + 4 * ai + m] = acc[ai][0][m][n][i]; g[1 + 4 * ai + m] = acc[ai][1][m][n][i]; }
                const float au = __shfl_up(a[8], 1, 16), ad = __shfl_down(a[1], 1, 16), gu = __shfl_up(g[8], 1, 16), gd = __shfl_down(g[1], 1, 16);
                a[0] = fr == 0 ? 0.f : au; a[9] = fr == 15 ? 0.f : ad; g[0] = fr == 0 ? 0.f : gu; g[9] = fr == 15 ? 0.f : gd;
#pragma unroll
                for (int j = 0; j < 8; ++j) {
                    const float ca = wa0[i] * a[j] + wa1[i] * a[j + 1] + wa2[i] * a[j + 2];
                    const float cg = wg0[i] * g[j] + wg1[i] * g[j + 1] + wg2[i] * g[j + 2];
                    act[j][i] = silu_f(cg) * ca;
                }
            }
#pragma unroll
            for (int j = 0; j < 8; ++j) { pk[j][2 * n] = cvt_pk_bf16(act[j][0], act[j][1]); pk[j][2 * n + 1] = cvt_pk_bf16(act[j][2], act[j][3]); }
        }
#pragma unroll
        for (int j = 0; j < 8; ++j) { u32x4 w; w.x = pk[j][0]; w.y = pk[j][1]; w.z = pk[j][2]; w.w = pk[j][3]; *(u32x4*)(ACT + (size_t)(rbase + j) * DFF + ch0) = w; }
        if (fr == 0 || fr == 15) {
            float* hp = HALO + (size_t)(seg * 4 + (fr == 0 ? 0 : 2)) * DUP + ch0;
#pragma unroll
            for (int bj = 0; bj < 2; ++bj)
#pragma unroll
                for (int n = 0; n < 2; ++n) {
                    const f32x4 r0 = fr == 0 ? acc[0][bj][0][n] : acc[1][bj][2][n], r1 = fr == 0 ? acc[0][bj][1][n] : acc[1][bj][3][n];
                    *(f32x4*)(hp + bj * DFF + 4 * n) = r0; *(f32x4*)(hp + DUP + bj * DFF + 4 * n) = r1;
                }
        }
    }
};
}

__device__ __forceinline__ int win_map(int L) {
    if (L < 1536) { const int T = L >> 8, l = L & 255, head = l >> 6, d = l & 63; return 256 * T + 128 * (d >> 5) + 32 * head; }
    if (L < 1792) { const int ch = L - 1536; return 256 * (6 + (ch >> 7)) + (ch & 127); }
    const int ch = L - 1792; return 256 * (6 + (ch >> 7)) + 128 + (ch & 127);
}
__device__ __forceinline__ int up_map(int L) { if (L < DFF) return 256 * (L >> 7) + (L & 127); const int ch = L - DFF; return 256 * (ch >> 7) + 128 + (ch & 127); }
template <int MAP> __device__ __forceinline__ void transpose_item(const float* W, int K, int N, bf16* WT, LAS float* scr, int item, int lane) {
    const int nblk = N / 32, kb = item / nblk, nb = item % nblk, k0 = 64 * kb, n0 = 32 * nb;
    const int r0 = MAP == 1 ? win_map(n0) : (MAP == 2 ? up_map(n0) : n0);
    float tmp[32];
#pragma unroll
    for (int i = 0; i < 32; ++i) tmp[i] = W[(size_t)(k0 + 2 * i + (lane >> 5)) * N + n0 + (lane & 31)];
#pragma unroll
    for (int i = 0; i < 32; ++i) scr[(2 * i + (lane >> 5)) * 33 + (lane & 31)] = tmp[i];
    asm volatile("s_waitcnt lgkmcnt(0)" ::: "memory");
    const int c = lane & 7;
#pragma unroll
    for (int j = 0; j < 4; ++j) { const int n = (lane >> 3) + 8 * j; const LAS float* s = scr + (8 * c) * 33 + n;
        v4u o; o.x = pk2(s[0 * 33], s[1 * 33]); o.y = pk2(s[2 * 33], s[3 * 33]); o.z = pk2(s[4 * 33], s[5 * 33]); o.w = pk2(s[6 * 33], s[7 * 33]);
        *(v4u*)(WT + pg8::wt_off(r0 + n, k0 + 8 * c, K / 64, MAP != 0)) = o; }
    asm volatile("s_waitcnt lgkmcnt(0)" ::: "memory");
}
constexpr int CI_IN = 16 * (DIN / 32), CI_OUT = 16 * 32, CI_UP = 16 * (DUP / 32), CI_DN = (DFF / 64) * 32, CONV_ITEMS = CI_IN + CI_OUT + CI_UP + CI_DN;
__device__ __forceinline__ void convert_item(int it, int l, const float* w_in, const float* w_out, const float* ffn_up, const float* ffn_down, unsigned char* ws, LAS float* scr, int lane) {
    unsigned char* wl_ = ws + ((l & 1) ? WS_W1 : WS_W0); int r = it;
    if (r < CI_IN) { transpose_item<1>(w_in + (size_t)l * 1024 * DIN, 1024, DIN, (bf16*)(wl_ + WO_WIN), scr, r, lane); return; } r -= CI_IN;
    if (r < CI_OUT) { transpose_item<3>(w_out + (size_t)l * 1024 * 1024, 1024, 1024, (bf16*)(wl_ + WO_WOUT), scr, r, lane); return; } r -= CI_OUT;
    if (r < CI_UP) { transpose_item<2>(ffn_up + (size_t)l * 1024 * DUP, 1024, DUP, (bf16*)(wl_ + WO_WUP), scr, r, lane); return; } r -= CI_UP;
    transpose_item<3>(ffn_down + (size_t)l * DFF * 1024, DFF, 1024, (bf16*)(wl_ + WO_WDN), scr, r, lane);
}
struct ConvItem { const float* W; bf16* WT; int K, N, map, item; };
__device__ __forceinline__ ConvItem conv_decode(int it, int l, const float* w_in, const float* w_out, const float* ffn_up, const float* ffn_down, unsigned char* ws) {
    unsigned char* wl_ = ws + ((l & 1) ? WS_W1 : WS_W0); ConvItem c; int r = it;
    if (r < CI_IN) { c.W = w_in + (size_t)l * 1024 * DIN; c.WT = (bf16*)(wl_ + WO_WIN); c.K = 1024; c.N = DIN; c.map = 1; c.item = r; return c; } r -= CI_IN;
    if (r < CI_OUT) { c.W = w_out + (size_t)l * 1024 * 1024; c.WT = (bf16*)(wl_ + WO_WOUT); c.K = 1024; c.N = 1024; c.map = 3; c.item = r; return c; } r -= CI_OUT;
    if (r < CI_UP) { c.W = ffn_up + (size_t)l * 1024 * DUP; c.WT = (bf16*)(wl_ + WO_WUP); c.K = 1024; c.N = DUP; c.map = 2; c.item = r; return c; } r -= CI_UP;
    c.W = ffn_down + (size_t)l * DFF * 1024; c.WT = (bf16*)(wl_ + WO_WDN); c.K = DFF; c.N = 1024; c.map = 3; c.item = r; return c;
}
__device__ __forceinline__ void conv_load(const ConvItem& c, int lane, float (&tmp)[32]) {
    const int nblk = c.N / 32, kb = c.item / nblk, nb = c.item % nblk, k0 = 64 * kb, n0 = 32 * nb;
#pragma unroll
    for (int i = 0; i < 32; ++i) tmp[i] = c.W[(size_t)(k0 + 2 * i + (lane >> 5)) * c.N + n0 + (lane & 31)];
}
__device__ __forceinline__ void conv_finish(const ConvItem& c, const float (&tmp)[32], LAS float* scr, int lane) {
    const int nblk = c.N / 32, kb = c.item / nblk, nb = c.item % nblk, k0 = 64 * kb, n0 = 32 * nb;
    const int r0 = c.map == 1 ? win_map(n0) : (c.map == 2 ? up_map(n0) : n0);
#pragma unroll
    for (int i = 0; i < 32; ++i) scr[(2 * i + (lane >> 5)) * 33 + (lane & 31)] = tmp[i];
    asm volatile("s_waitcnt lgkmcnt(0)" ::: "memory");
    const int cc = lane & 7;
#pragma unroll
    for (int j = 0; j < 4; ++j) { const int n = (lane >> 3) + 8 * j; const LAS float* sp = scr + (8 * cc) * 33 + n;
        v4u o; o.x = pk2(sp[0 * 33], sp[1 * 33]); o.y = pk2(sp[2 * 33], sp[3 * 33]); o.z = pk2(sp[4 * 33], sp[5 * 33]); o.w = pk2(sp[6 * 33], sp[7 * 33]);
        *(v4u*)(c.WT + pg8::wt_off(r0 + n, k0 + 8 * cc, c.K / 64, true)) = o; }
    asm volatile("s_waitcnt lgkmcnt(0)" ::: "memory");
}
#define CONV_RUN(FIRST, STRIDE, LIMIT, LAYER_OF, ITEM_OF) do { \
    for (int it_ = (FIRST); it_ < (LIMIT); it_ += 2 * (STRIDE)) { const int it2_ = it_ + (STRIDE); const bool two_ = it2_ < (LIMIT); \
        const ConvItem ca_ = conv_decode(ITEM_OF(it_), LAYER_OF(it_), w_in, w_out, ffn_up, ffn_down, (unsigned char*)ws); \
        const ConvItem cb_ = conv_decode(ITEM_OF(two_ ? it2_ : it_), LAYER_OF(two_ ? it2_ : it_), w_in, w_out, ffn_up, ffn_down, (unsigned char*)ws); \
        float ta_[32], tb_[32]; conv_load(ca_, lane, ta_); conv_load(cb_, lane, tb_); \
        conv_finish(ca_, ta_, scr, lane); if (two_) conv_finish(cb_, tb_, scr, lane); } } while (0)
__device__ __forceinline__ void norm_load(const float* xrow, int lane, f32x4 (&v)[4]) {
    const f32x4* xr = (const f32x4*)xrow + lane;
#pragma unroll
    for (int j = 0; j < 4; ++j) v[j] = xr[64 * j];
}
__device__ __forceinline__ void norm_load_bf(const bf16* xrow, int lane, f32x4 (&v)[4]) {
    const v2u* xr = (const v2u*)xrow + lane;
#pragma unroll
    for (int j = 0; j < 4; ++j) { const v2u w = xr[64 * j]; v[j] = (f32x4){bf_lo(w.x), bf_hi(w.x), bf_lo(w.y), bf_hi(w.y)}; }
}
__device__ __forceinline__ void norm_finish(const f32x4 (&v)[4], const float* g, const float* sh, const float* sc, bf16* orow, int lane) {
    float s = 0.f;
#pragma unroll
    for (int j = 0; j < 4; ++j) s += (v[j].x * v[j].x + v[j].y * v[j].y) + (v[j].z * v[j].z + v[j].w * v[j].w);
    const float r = rsqrtf(wave_sum(s) * (1.f / 1024.f) + EPS);
    v2u* o8 = (v2u*)orow + lane;
#pragma unroll
    for (int j = 0; j < 4; ++j) {
        const f32x4 gg = ((const f32x4*)g)[lane + 64 * j], ss = ((const f32x4*)sh)[lane + 64 * j], cc = ((const f32x4*)sc)[lane + 64 * j];
        const f32x4 y = (v[j] * r * gg) * (cc + 1.f) + ss;
        v2u w; w.x = pk2(y.x, y.y); w.y = pk2(y.z, y.w); o8[64 * j] = w; }
}
#define NORM_ROWS(XLAT, XCTX, GAIN, MODP, SHI, SCI) do { \
    for (int m = gw; m < MROWS; m += 2 * NGW) { const int m2 = m + NGW; const bool has2 = m2 < MROWS; const int mb = has2 ? m2 : m; \
        f32x4 va[4], vb[4]; \
        if (m < NLAT) norm_load_bf((XLAT) + (size_t)m * 1024, lane, va); else norm_load((XCTX) + (size_t)(m - NLAT) * 1024, lane, va); \
        if (mb < NLAT) norm_load_bf((XLAT) + (size_t)mb * 1024, lane, vb); else norm_load((XCTX) + (size_t)(mb - NLAT) * 1024, lane, vb); \
        { const int s_ = m < SEQL ? 0 : (m < NLAT ? 1 : 2); norm_finish(va, (GAIN), (MODP) + (size_t)(s_ * 6 + (SHI)) * 1024, (MODP) + (size_t)(s_ * 6 + (SCI)) * 1024, H + (size_t)m * 1024, lane); } \
        if (has2) { const int s_ = mb < SEQL ? 0 : (mb < NLAT ? 1 : 2); norm_finish(vb, (GAIN), (MODP) + (size_t)(s_ * 6 + (SHI)) * 1024, (MODP) + (size_t)(s_ * 6 + (SCI)) * 1024, H + (size_t)mb * 1024, lane); } \
    } } while (0)

#define XB_TMO      128
#define XB_XCNT(j)  (256  + 64 * (j))
#define XB_XSUB(j)  (1280 + 64 * (j))
#define XB_XGEN(j)  (2304 + 64 * (j))
#define XB_TOP      3328
#define XB_TOPGEN   3392
#define XCD_BAR_WORDS 3456
#define XB_SPIN_CAP (1u << 18)

__device__ __forceinline__ unsigned xb_ld(unsigned* p)              { return __hip_atomic_load(p, __ATOMIC_RELAXED, __HIP_MEMORY_SCOPE_AGENT); }
__device__ __forceinline__ unsigned xb_add(unsigned* p, unsigned v) { return __hip_atomic_fetch_add(p, v, __ATOMIC_RELAXED, __HIP_MEMORY_SCOPE_AGENT); }
__device__ __forceinline__ unsigned xb_xcc_id() { return (unsigned)__builtin_amdgcn_s_getreg((3 << 11) | 20) & 0xFu; }
#define XB_SPIN(cond, bar) do { unsigned _sp = 0; while (cond) { __builtin_amdgcn_s_sleep(1); \
    if ((++_sp & 255u) == 0u) { if (xb_ld(&(bar)[XB_TMO])) break; if (_sp > XB_SPIN_CAP) { atomicAdd(&(bar)[XB_TMO], 1u); break; } } } } while (0)

struct XcdBarrier {
    unsigned* bar; unsigned x;
    volatile LAS unsigned* st;
};

__device__ __forceinline__ XcdBarrier xcd_barrier_post(unsigned* bar, volatile LAS unsigned* st) {
    XcdBarrier b; b.bar = bar; b.x = xb_xcc_id(); b.st = st;
    if (threadIdx.x == 0) (void)xb_add(&bar[XB_XCNT(b.x)], 1u);
    return b;
}
__device__ __forceinline__ void xcd_barrier_complete(unsigned* bar, unsigned x, unsigned& nloc, unsigned& nx) {
    const unsigned G = gridDim.x * gridDim.y * gridDim.z;
    unsigned sum, cnt, mine, sp = 0u;
    for (;;) {
        sum = 0u; cnt = 0u; mine = 0u;
#pragma unroll
        for (unsigned j = 0; j < 16; ++j) { const unsigned c = xb_ld(&bar[XB_XCNT(j)]); sum += c; cnt += (c > 0u) ? 1u : 0u; mine = (j == x) ? c : mine; }
        if (sum == G) break;
        __builtin_amdgcn_s_sleep(1);
        if ((++sp & 255u) == 0u) { if (xb_ld(&bar[XB_TMO])) break; if (sp > XB_SPIN_CAP) { atomicAdd(&bar[XB_TMO], 1u); break; } }
    }
    nloc = mine > 0u ? mine : 1u; nx = cnt > 0u ? cnt : 1u;
}

__device__ __forceinline__ void xcd_barrier(const XcdBarrier& b_) {
    XcdBarrier b = b_; asm volatile("" : "+s"(b.bar), "+s"(b.x));
    asm volatile("s_waitcnt vmcnt(0)" ::: "memory");
    __syncthreads();
    if (threadIdx.x == 0) {
        unsigned* bar = b.bar;
        __builtin_amdgcn_s_waitcnt(0);
        unsigned nloc = b.st[0], nx = b.st[1];
        if (nloc == 0u) { xcd_barrier_complete(bar, b.x, nloc, nx); b.st[0] = nloc; b.st[1] = nx; }
        const unsigned old = xb_add(&bar[XB_XSUB(b.x)], 1u);
        const unsigned gen = old / nloc;
        if (old + 1u == (gen + 1u) * nloc) {
            __builtin_amdgcn_fence(__ATOMIC_RELEASE, "agent");
            asm volatile("s_waitcnt vmcnt(0)" ::: "memory");
            const unsigned og = xb_add(&bar[XB_TOP], 1u);
            const unsigned tg = og / nx;
            if (og + 1u == (tg + 1u) * nx) xb_add(&bar[XB_TOPGEN], 1u);
            else XB_SPIN(xb_ld(&bar[XB_TOPGEN]) == tg, bar);
            __builtin_amdgcn_fence(__ATOMIC_ACQUIRE, "agent");
            xb_add(&bar[XB_XGEN(b.x)], 1u);
            asm volatile("s_waitcnt vmcnt(0)" ::: "memory");
        } else {
            XB_SPIN(xb_ld(&bar[XB_XGEN(b.x)]) == gen, bar);
            __builtin_amdgcn_fence(__ATOMIC_ACQUIRE, "agent");
            asm volatile("s_waitcnt vmcnt(0)" ::: "memory");
        }
    }
    __syncthreads();
}


template <int RT, int NKS, class BOff> __device__ __forceinline__ void small_gemm(const bf16* A, int lda, const bf16* Bw, BOff boff, LAS float* red, int lane, int wave) {
    const int li = lane & 15, kq = lane >> 4, kbase = wave * (NKS * 32) + 8 * kq;
    f32x4 acc[RT][4];
#pragma unroll
    for (int rt = 0; rt < RT; ++rt)
#pragma unroll
        for (int ct = 0; ct < 4; ++ct) acc[rt][ct] = (f32x4){0.f, 0.f, 0.f, 0.f};
    const bf16* ap[RT];
#pragma unroll
    for (int rt = 0; rt < RT; ++rt) ap[rt] = A + (size_t)(16 * rt + li) * lda + kbase;
#pragma unroll
    for (int ks = 0; ks < NKS; ++ks) {
        bf16x8 a[RT], b[4];
#pragma unroll
        for (int rt = 0; rt < RT; ++rt) a[rt] = *(const bf16x8*)(ap[rt] + 32 * ks);
#pragma unroll
        for (int ct = 0; ct < 4; ++ct) b[ct] = *(const bf16x8*)(Bw + boff(16 * ct + li, kbase + 32 * ks));
#pragma unroll
        for (int rt = 0; rt < RT; ++rt)
#pragma unroll
            for (int ct = 0; ct < 4; ++ct) acc[rt][ct] = __builtin_amdgcn_mfma_f32_16x16x32_bf16(b[ct], a[rt], acc[rt][ct], 0, 0, 0);
    }
#pragma unroll
    for (int rt = 0; rt < RT; ++rt)
#pragma unroll
        for (int ct = 0; ct < 4; ++ct) *(LAS f32x4*)(red + ((size_t)wave * (16 * RT) + 16 * rt + li) * 64 + 16 * ct + 4 * kq) = acc[rt][ct];
}
__device__ __forceinline__ void st8g(bf16* p, const float (&o)[8]) { v4u w; w.x = pk2(o[0], o[1]); w.y = pk2(o[2], o[3]); w.z = pk2(o[4], o[5]); w.w = pk2(o[6], o[7]); *(v4u*)p = w; }

__device__ __forceinline__ void final_finish(const f32x4 (&v)[4], const float* g, float* orow, int lane) {
    float s = 0.f;
#pragma unroll
    for (int j = 0; j < 4; ++j) s += (v[j].x * v[j].x + v[j].y * v[j].y) + (v[j].z * v[j].z + v[j].w * v[j].w);
    const float r = rsqrtf(wave_sum(s) * (1.f / 1024.f) + EPS);
#pragma unroll
    for (int j = 0; j < 4; ++j) ((f32x4*)orow)[lane + 64 * j] = v[j] * r * ((const f32x4*)g)[lane + 64 * j];
}
__device__ __forceinline__ void panel_norm(unsigned* cnt, int pm, int pn, int vcu, const bf16* xlat, float* outf, const float* xctx, const float* gain, const float* modp, int shi, int sci, bf16* H, bool fin, bool doctx, int tid, int lane, int wave) {
    asm volatile("s_waitcnt vmcnt(0)" ::: "memory");
    __syncthreads();
    const int rt = vcu >> 4;
    if (tid == 0) {
        __builtin_amdgcn_fence(__ATOMIC_RELEASE, "agent"); asm volatile("s_waitcnt vmcnt(0)" ::: "memory");
        (void)xb_add(cnt + pm, 1u); (void)xb_add(cnt + 64 + rt, 1u);
        unsigned sp = 0; while (xb_ld(cnt + pm) < 4u || (doctx && xb_ld(cnt + 64 + rt) < 16u)) { __builtin_amdgcn_s_sleep(1); if (++sp > (1u << 22)) break; }
        __builtin_amdgcn_fence(__ATOMIC_ACQUIRE, "agent"); asm volatile("s_waitcnt vmcnt(0)" ::: "memory");
    }
    __syncthreads();
    const int s = pm < 32 ? 0 : 1;
    {
        const int r0 = 256 * pm + 64 * pn + 8 * wave;
        f32x4 v8[8][4], vc[4];
#pragma unroll
        for (int i = 0; i < 8; ++i) norm_load_bf(xlat + (size_t)(r0 + i) * 1024, lane, v8[i]);
        const int cr = 32 * rt + 2 * (vcu & 15) + (wave & 1);
        if (doctx && wave < 2) norm_load(xctx + (size_t)cr * 1024, lane, vc);
        asm volatile("" ::: "memory");
#pragma unroll
        for (int i = 0; i < 8; ++i) {
            if (fin) final_finish(v8[i], gain, outf + (size_t)(r0 + i) * 1024, lane);
            else norm_finish(v8[i], gain, modp + (size_t)(s * 6 + shi) * 1024, modp + (size_t)(s * 6 + sci) * 1024, H + (size_t)(r0 + i) * 1024, lane);
        }
        if (doctx && wave < 2) norm_finish(vc, gain, modp + (size_t)(2 * 6 + shi) * 1024, modp + (size_t)(2 * 6 + sci) * 1024, H + (size_t)(NLAT + cr) * 1024, lane);
    }
}

struct Args { const float* in[19]; float* out; unsigned char* ws; unsigned long long zero; };

__global__ void __launch_bounds__(NTHR, 2) fwd_megakernel(Args args) {
    extern __shared__ __attribute__((aligned(16))) unsigned char lds_raw[];
    cg::grid_group grid = cg::this_grid();
    LAS unsigned char* lds = (LAS unsigned char*)lds_raw;
    const int G = gridDim.x; const int bx = blockIdx.x;
    const int vcu = (G % 8 == 0) ? (bx % 8) * (G / 8) + bx / 8 : bx;
    const int NGW = G * NWAVES;
    constexpr int F_UNITS = (MROWS / 256) * (DUP / 256);
    const int f_rem = F_UNITS % G, n_idle = G - f_rem;
    const bool hide_conv = (f_rem != 0) && (n_idle >= 32);
#define PHASE_IDS() int tid_ = threadIdx.x; asm volatile("" : "+v"(tid_)); const int tid = tid_, lane = tid & 63, wave = __builtin_amdgcn_readfirstlane(tid >> 6), gw = vcu * NWAVES + wave; (void)tid; (void)lane; (void)wave; (void)gw

    unsigned char* const ws0 = args.ws;
#define PHASE_PTRS() GAS_ unsigned char* ws = (GAS_ unsigned char*)ws0; asm volatile("" : "+s"(ws)); GAS_ const float* GAS_ const* pt = (GAS_ const float* GAS_ const*)(ws + WS_PTRS); \
    const float* x_in = (const float*)pt[0]; const float* ctx_in = (const float*)pt[2]; const float* norm1_g = (const float*)pt[6]; const float* w_in = (const float*)pt[7]; const float* q_norm_g = (const float*)pt[8]; const float* k_norm_g = (const float*)pt[9]; \
    const float* gmlp_w = (const float*)pt[10]; const float* gmlp_b = (const float*)pt[11]; const float* conv_c_w = (const float*)pt[12]; const float* w_out = (const float*)pt[13]; const float* norm2_g = (const float*)pt[14]; const float* ffn_up = (const float*)pt[15]; \
    const float* ffn_conv_w = (const float*)pt[16]; const float* ffn_down = (const float*)pt[17]; const float* final_g = (const float*)pt[18]; float* out = (float*)pt[19]; \
    float* MODV = (float*)(ws + WS_MODV); f32x2* ROPE = (f32x2*)(ws + WS_ROPE); float* XSC = (float*)(ws + WS_XSC); \
    GAS_ unsigned char* wl_ = ws + ((l & 1) ? WS_W1 : WS_W0); bf16* XB = (bf16*)(ws + WS_XB); (void)XB; bf16* WIN = (bf16*)(wl_ + WO_WIN); bf16* WOUT = (bf16*)(wl_ + WO_WOUT); bf16* WUP = (bf16*)(wl_ + WO_WUP); bf16* WDN = (bf16*)(wl_ + WO_WDN); unsigned* CNT = (unsigned*)(ws + WS_CNT); \
    bf16* ACT = (bf16*)(ws + WS_ACT); bf16* H = (bf16*)(ws + WS_H); float* HALO = (float*)(ws + WS_HALO); \
    bf16* Qb = (bf16*)(ws + WS_Q); bf16* Kb = (bf16*)(ws + WS_K); bf16* Vb = (bf16*)(ws + WS_V); bf16* Ub = (bf16*)(ws + WS_U); \
    bf16* VNb = (bf16*)(ws + WS_VN); bf16* CBb = (bf16*)(ws + WS_CB); bf16* CCHb = (bf16*)(ws + WS_CCH); bf16* MIX = (bf16*)(ws + WS_MIX); \
    const float* modl = MODV + (size_t)l * 3 * 6144; const float* cur_ctx = (l == 0) ? ctx_in : XSC; \
    (void)x_in; (void)ctx_in; (void)norm1_g; (void)w_in; (void)q_norm_g; (void)k_norm_g; (void)gmlp_w; (void)gmlp_b; (void)conv_c_w; (void)w_out; (void)norm2_g; (void)ffn_up; (void)ffn_conv_w; (void)ffn_down; (void)final_g; (void)out; \
    (void)CNT; (void)MODV; (void)ROPE; (void)XSC; (void)WIN; (void)WOUT; (void)WUP; (void)WDN; (void)ACT; (void)H; (void)HALO; (void)Qb; (void)Kb; (void)Vb; (void)Ub; (void)VNb; (void)CBb; (void)CCHb; (void)MIX; (void)modl; (void)cur_ctx
    unsigned char* ws = args.ws;
    if (bx == 0 && threadIdx.x < 20) { const float* p = threadIdx.x < 19 ? args.in[threadIdx.x] : (const float*)args.out; ((const float**)(ws + WS_PTRS))[threadIdx.x] = p; }
    const float* c_in = args.in[1]; const float* cctx_in = args.in[3]; const float* w_mod = args.in[4]; const float* b_mod = args.in[5];
    float* MODV = (float*)(ws + WS_MODV); f32x2* ROPE = (f32x2*)(ws + WS_ROPE);
    unsigned* barw = (unsigned*)(ws + WS_BAR);
    { const int t0 = threadIdx.x;
      for (int u = t0; u < (LDS_BYTES - RING_BYTES) / 4; u += NTHR) ((LAS unsigned*)(lds + RING_BYTES))[u] = 0u;
    }
    __syncthreads();
    const XcdBarrier xbar = xcd_barrier_post(barw, (volatile LAS unsigned*)(lds + RING_BYTES + 64));
#ifndef SKIP_P0
        for (int rep_ = 0; rep_ < REP_P0; ++rep_) { if (rep_) __syncthreads();
        { PHASE_IDS();
    {
        LAS float* sc = (LAS float*)lds;
        LAS float* part = (LAS float*)(lds + 16384);
        for (int i = tid; i < 3072; i += NTHR) { const int s = i >> 10, k = i & 1023; const float cv = s < 2 ? c_in[s * 1024 + k] : cctx_in[k]; sc[i] = silu_f(cv); }
        __syncthreads();
        for (int unit = vcu; unit < NLAYER * 192; unit += G) {
            const int l = unit / 192, j0 = (unit % 192) * 32, hlf = lane >> 5, cl = lane & 31, k0 = wave * 128 + hlf * 64;
            const float* wp = w_mod + (size_t)l * 1024 * 6144 + (size_t)k0 * 6144 + j0 + cl;
            float a0 = 0.f, a1 = 0.f, a2 = 0.f;
#pragma unroll 32
            for (int k = 0; k < 64; ++k) { const float wv = wp[(size_t)k * 6144]; a0 += sc[k0 + k] * wv; a1 += sc[1024 + k0 + k] * wv; a2 += sc[2048 + k0 + k] * wv; }
            a0 += __shfl_xor(a0, 32); a1 += __shfl_xor(a1, 32); a2 += __shfl_xor(a2, 32);
            if (lane < 32) { part[(wave * 3 + 0) * 32 + cl] = a0; part[(wave * 3 + 1) * 32 + cl] = a1; part[(wave * 3 + 2) * 32 + cl] = a2; }
            __syncthreads();
            if (tid < 96) { const int s = tid >> 5, j = tid & 31; float t = b_mod[l * 6144 + j0 + j];
#pragma unroll
                for (int w = 0; w < 8; ++w) t += part[(w * 3 + s) * 32 + j];
                MODV[(size_t)(l * 3 + s) * 6144 + j0 + j] = t; }
            __syncthreads();
        }
        if (bx == 0) {
            for (int e = tid; e < 2048; e += NTHR) {
                const int pos = e >> 4, f = e & 15;
                double th = 1.0; for (int i = 0; i < f; ++i) th *= 0.5623413251903491;
                const double a = (double)pos * th;
                const double kk = __builtin_rint(a * 0.15915494309189535);
                const double xr = (a - kk * 6.283185307179586) - kk * 2.4492935982947064e-16;
                const double x2 = xr * xr; double sn = xr, cs = 1.0, ts = xr, tc = 1.0;
                for (int n = 1; n <= 14; ++n) { tc *= -x2 / (double)((2 * n - 1) * (2 * n)); cs += tc; ts *= -x2 / (double)((2 * n) * (2 * n + 1)); sn += ts; }
                ROPE[e] = (f32x2){(float)cs, (float)sn};
            }
        }
        __syncthreads();
        {
            LAS float* scr = (LAS float*)(lds + wave * 16384);
            const float* w_in = args.in[7]; const float* w_out = args.in[13]; const float* ffn_up = args.in[15]; const float* ffn_down = args.in[17];
            const int nl = 1;
#define L_OF_(i) ((i) / CONV_ITEMS)
#define I_OF_(i) ((i) % CONV_ITEMS)
            CONV_RUN(gw, NGW, nl * CONV_ITEMS, L_OF_, I_OF_);
#undef L_OF_
#undef I_OF_
        }
    }
        }
        }
#endif
    if (args.zero) grid.sync();
    xcd_barrier(xbar);

    const bool fused = (G == 256);
    { PHASE_IDS(); const int l = 0; PHASE_PTRS();
      for (int m = gw; m < MROWS; m += NGW) {
          f32x4 va[4]; const int s_ = m < SEQL ? 0 : (m < NLAT ? 1 : 2);
          if (m < NLAT) { norm_load(x_in + (size_t)m * 1024, lane, va); v2u* xo = (v2u*)(XB + (size_t)m * 1024) + lane;
#pragma unroll
              for (int j = 0; j < 4; ++j) { v2u w; w.x = pk2(va[j].x, va[j].y); w.y = pk2(va[j].z, va[j].w); xo[64 * j] = w; } }
          else norm_load(ctx_in + (size_t)(m - NLAT) * 1024, lane, va);
          norm_finish(va, norm1_g, modl + (size_t)(s_ * 6 + 0) * 1024, modl + (size_t)(s_ * 6 + 1) * 1024, H + (size_t)m * 1024, lane);
      }
    }
    xcd_barrier(xbar);
#pragma unroll 1
    for (int l = 0; l < NLAYER; ++l) {
#ifndef SKIP_PB
        for (int rep_ = 0; rep_ < REP_PB; ++rep_) { if (rep_) xcd_barrier(xbar);
        {
            PHASE_PTRS();
            pg8::Gemm g{H, WIN, NLAT, DIN, 1024}; pg8::StaticOrder S; S.init(NLAT, DIN, G, bx);
            pg8::EpiProj E{Qb, Kb, Vb, Ub, VNb, CBb, CCHb, q_norm_g + l * 64, k_norm_g + l * 64, ROPE};
            pg8::gemm_phase<pg8::EpiProj, pg8::StaticOrder, PG8_ALIGN, PG8_SP2>(lds, g, S, E);
        }
        {
            PHASE_IDS(); PHASE_PTRS();
            LAS float* red = (LAS float*)lds;
            for (int tile = vcu; tile < 256; tile += G) {
                const int rtile = tile >> 5, T = (tile >> 2) & 7, wc = tile & 3;
                small_gemm<4, 4>(H + (size_t)(NLAT + 64 * rtile) * 1024, 1024, WIN, [&](int c, int k) { return pg8::wt_off(256 * T + 128 * (c >> 5) + 32 * wc + (c & 31), k, 16, true); }, red, lane, wave);
                __syncthreads();
                const int r = tid >> 3, d0 = (tid & 7) * 8; const int cr = 64 * rtile + r, gm = NLAT + cr;
                float v[8];
#pragma unroll
                for (int k = 0; k < 8; ++k) v[k] = 0.f;
#pragma unroll
                for (int w = 0; w < 8; ++w) { const f32x4 p0 = *(const LAS f32x4*)(red + ((size_t)w * 64 + r) * 64 + d0), p1 = *(const LAS f32x4*)(red + ((size_t)w * 64 + r) * 64 + d0 + 4);
                    v[0] += p0.x; v[1] += p0.y; v[2] += p0.z; v[3] += p0.w; v[4] += p1.x; v[5] += p1.y; v[6] += p1.z; v[7] += p1.w; }
                const int kvb = cr >> 8, kvr = cr & 255;
                float o[8];
                if (T == 0) {
#pragma unroll
                    for (int k = 0; k < 8; ++k) o[k] = gelu_t(v[k]);
                    st8g(Ub + (size_t)gm * 256 + 64 * wc + d0, o);
                } else if (T == 1) {
                    float sm = 0.f;
#pragma unroll
                    for (int k = 0; k < 8; ++k) { v[k] = gelu_t(v[k]); sm += v[k]; }
                    sm += __shfl_xor(sm, 1); sm += __shfl_xor(sm, 2); sm += __shfl_xor(sm, 4);
                    const float mean = sm * (1.f / 64.f); float q = 0.f;
#pragma unroll
                    for (int k = 0; k < 8; ++k) { v[k] -= mean; q += v[k] * v[k]; }
                    q += __shfl_xor(q, 1); q += __shfl_xor(q, 2); q += __shfl_xor(q, 4);
                    const float rstd = rsqrtf(q * (1.f / 64.f) + EPS);
#pragma unroll
                    for (int k = 0; k < 8; ++k) o[k] = v[k] * rstd;
                    st8g(VNb + (size_t)gm * 256 + 64 * wc + d0, o);
                } else if (T == 2 || T == 3 || (T == 4 && wc < 2)) {
                    float ss = 0.f;
#pragma unroll
                    for (int k = 0; k < 8; ++k) ss += v[k] * v[k];
                    ss += __shfl_xor(ss, 1); ss += __shfl_xor(ss, 2); ss += __shfl_xor(ss, 4);
                    const float rr = rsqrtf(ss * (1.f / 64.f) + EPS);
                    const float* gp = (T == 4 ? k_norm_g : q_norm_g) + l * 64 + d0; const float osc = (T == 4) ? 1.f : QSCALE;
#pragma unroll
                    for (int k = 0; k < 8; ++k) o[k] = v[k] * rr * gp[k] * osc;
                    if (T == 4) st8g(Kb + ((((size_t)(kvb * 2 + wc) * (KVROWS / 64) + (kvr >> 6)) * 8 + (d0 >> 3)) * 64 + (kvr & 63)) * 8, o); else st8g(Qb + (size_t)gm * 512 + 64 * (4 * (T - 2) + wc) + d0, o);
                } else if (T == 4) {
                    st8g(Vb + ((((size_t)(kvb * 2 + wc - 2) * (KVROWS / 64) + (kvr >> 6)) * 8 + ((d0 >> 5) * 4 + ((kvr >> 4) & 3))) * 16 + (kvr & 15)) * 32 + (d0 & 31), v);
                } else if (T == 5) {
                    st8g(CBb + (size_t)gm * 256 + 64 * wc + d0, v);
                } else {
#pragma unroll
                    for (int k = 0; k < 8; ++k) o[k] = v[k] * __shfl_xor(v[k], 4);
                    if (d0 < 32) st8g(CCHb + (size_t)gm * 256 + 128 * (T - 6) + 32 * wc + d0, o);
                }
                __syncthreads();
            }
        }
        }
#endif
        xcd_barrier(xbar);
#ifndef SKIP_PC
        for (int rep_ = 0; rep_ < REP_PC; ++rep_) { if (rep_) xcd_barrier(xbar);
        { PHASE_IDS(); PHASE_PTRS();
        {
            float gqm = fabsf(q_norm_g[l * 64 + lane]), gkm = fabsf(k_norm_g[l * 64 + lane]);
#pragma unroll
            for (int o = 1; o < 64; o <<= 1) { gqm = fmaxf(gqm, __shfl_xor(gqm, o)); gkm = fmaxf(gkm, __shfl_xor(gkm, o)); }
            const float mstat = __builtin_amdgcn_readfirstlane(64.f * QSCALE * 1.01f * gqm * gkm);
            const bool use_static = mstat <= 30.f;
            for (int i = 0;; ++i) {
                const int u = vcu + i * G; if (u >= (l == NLAYER - 1 ? 512 : 528)) break;
                const attn_body::bf16 *Qu, *Kh, *Vh; attn_body::bf16* Ou; int NT;
                if (u < 512) { const int bg = u >> 7, b = bg >> 1, g = bg & 1, rem = u & 127, qh = g * 4 + (rem >> 5), qb = rem & 31;
                    const size_t r0 = (size_t)b * SEQL + qb * 256;
                    Qu = (const attn_body::bf16*)Qb + r0 * 512 + qh * 64; Ou = (attn_body::bf16*)MIX + r0 * 1024 + 256 + qh * 64;
                    Kh = (const attn_body::bf16*)Kb + (size_t)(b * 2 + g) * (KVROWS / 64) * 4096; Vh = (const attn_body::bf16*)Vb + (size_t)(b * 2 + g) * (KVROWS / 64) * 4096; NT = KVROWS / 64;
                } else { const int j = u - 512, b = j >> 3, qh = j & 7, g = qh >> 2;
                    const size_t r0 = (size_t)NLAT + b * CTXL;
                    Qu = (const attn_body::bf16*)Qb + r0 * 512 + qh * 64; Ou = (attn_body::bf16*)MIX + r0 * 1024 + 256 + qh * 64;
                    Kh = (const attn_body::bf16*)Kb + (size_t)(b * 2 + g) * (KVROWS / 64) * 4096; Vh = (const attn_body::bf16*)Vb + (size_t)(b * 2 + g) * (KVROWS / 64) * 4096; NT = CTXL / 64;
                }
                if (use_static) attn_body::attn_unit<8, true>(Qu, 512, Kh, Vh, 128, NT, Ou, 1024, (char*)lds_raw, mstat);
                else attn_body::attn_unit<8, false>(Qu, 512, Kh, Vh, 128, NT, Ou, 1024, (char*)lds_raw, 0.f);
            }
            __syncthreads();
            {
                constexpr int VP = 72;
                LAS bf16* vt = (LAS bf16*)lds;
                for (int unit = (vcu + G / 2) % G; unit < ((l == NLAYER - 1 ? NLAT : MROWS) / 128) * 4; unit += G) {
                    const int ck = unit >> 2, h = unit & 3, m0 = ck * 128;
                    const int pi = lane & 15, kq = lane >> 4, p = wave * 16 + pi;
                    const float* wrow = gmlp_w + ((size_t)(l * 4 + h) * 128 + p) * 128;
                    const int trow = tid >> 2, chk = tid & 3; const bf16* src = VNb + (size_t)(m0 + trow) * 256 + h * 64 + chk * 16;
                    const v4u ta = *(const v4u*)src, tb = *(const v4u*)(src + 8);
                    f32x4 wf[4][2];
#pragma unroll
                    for (int ks = 0; ks < 4; ++ks) { wf[ks][0] = *(const f32x4*)(wrow + 32 * ks + 8 * kq); wf[ks][1] = *(const f32x4*)(wrow + 32 * ks + 8 * kq + 4); }
                    const float bias = gmlp_b[(l * 4 + h) * 128 + p];
                    v2u ug[4];
#pragma unroll
                    for (int nt = 0; nt < 4; ++nt) ug[nt] = *(const v2u*)(Ub + (size_t)(m0 + p) * 256 + h * 64 + 16 * nt + 4 * kq);
                    *(LAS v4u*)(vt + trow * VP + chk * 16) = ta; *(LAS v4u*)(vt + trow * VP + chk * 16 + 8) = tb;
                    __syncthreads();
                    bf16x8 bfr[4];
#pragma unroll
                    for (int ks = 0; ks < 4; ++ks) { const f32x4 w0 = wf[ks][0], w1 = wf[ks][1];
                        v4u t; t.x = pk2(w0.x, w0.y); t.y = pk2(w0.z, w0.w); t.z = pk2(w1.x, w1.y); t.w = pk2(w1.z, w1.w); bfr[ks] = __builtin_bit_cast(bf16x8, t); }
#pragma unroll
                    for (int nt = 0; nt < 4; ++nt) {
                        f32x4 d = {0.f, 0.f, 0.f, 0.f};
#pragma unroll
                        for (int ks = 0; ks < 4; ++ks) { bf16x8 af;
#pragma unroll
                            for (int jj = 0; jj < 8; ++jj) af[jj] = (short)vt[(32 * ks + 8 * kq + jj) * VP + 16 * nt + pi];
                            d = __builtin_amdgcn_mfma_f32_16x16x32_bf16(af, bfr[ks], d, 0, 0, 0); }
                        const size_t row = (size_t)(m0 + p); const int dc = h * 64 + 16 * nt + 4 * kq;
                        const v2u uu = ug[nt];
                        v2u o; o.x = pk2(bf_lo(uu.x) * (d[0] + bias), bf_hi(uu.x) * (d[1] + bias)); o.y = pk2(bf_lo(uu.y) * (d[2] + bias), bf_hi(uu.y) * (d[3] + bias));
                        *(v2u*)(MIX + row * 1024 + dc) = o;
                    }
                    __syncthreads();
                }
            }
            {
                const f32x4 w0 = ((const f32x4*)(conv_c_w + (size_t)l * 768))[lane], w1 = ((const f32x4*)(conv_c_w + (size_t)l * 768 + 256))[lane], w2 = ((const f32x4*)(conv_c_w + (size_t)l * 768 + 512))[lane];
                const int rows_per = (MROWS + G - 1) / G;
                constexpr int CU_ = 9;
                for (int i0 = wave; i0 < rows_per; i0 += NWAVES * CU_) {
                    v2u cm[CU_], cp[CU_], cn[CU_], cb[CU_]; int mm[CU_];
#pragma unroll
                    for (int u = 0; u < CU_; ++u) {
                        const int i = i0 + NWAVES * u; int m = vcu * rows_per + i; if (i >= rows_per || m >= (l == NLAYER - 1 ? NLAT : MROWS)) m = -1;
                        mm[u] = m; const int mc = m < 0 ? 0 : m;
                        const int t = mc < NLAT ? (mc & (SEQL - 1)) : ((mc - NLAT) & (CTXL - 1)); const int L = mc < NLAT ? SEQL : CTXL;
                        const v2u z = {0u, 0u};
                        cm[u] = *(const v2u*)(CCHb + (size_t)mc * 256 + 4 * lane);
                        cp[u] = t > 0 ? *(const v2u*)(CCHb + (size_t)(mc - 1) * 256 + 4 * lane) : z;
                        cn[u] = t < L - 1 ? *(const v2u*)(CCHb + (size_t)(mc + 1) * 256 + 4 * lane) : z;
                        cb[u] = *(const v2u*)(CBb + (size_t)mc * 256 + 4 * lane);
                    }
#pragma unroll
                    for (int u = 0; u < CU_; ++u) {
                        if (mm[u] < 0) continue;
                        const float o0 = bf_lo(cb[u].x) * (w0.x * bf_lo(cp[u].x) + w1.x * bf_lo(cm[u].x) + w2.x * bf_lo(cn[u].x));
                        const float o1 = bf_hi(cb[u].x) * (w0.y * bf_hi(cp[u].x) + w1.y * bf_hi(cm[u].x) + w2.y * bf_hi(cn[u].x));
                        const float o2 = bf_lo(cb[u].y) * (w0.z * bf_lo(cp[u].y) + w1.z * bf_lo(cm[u].y) + w2.z * bf_lo(cn[u].y));
                        const float o3 = bf_hi(cb[u].y) * (w0.w * bf_hi(cp[u].y) + w1.w * bf_hi(cm[u].y) + w2.w * bf_hi(cn[u].y));
                        v2u o; o.x = pk2(o0, o1); o.y = pk2(o2, o3);
                        *(v2u*)(MIX + (size_t)mm[u] * 1024 + 768 + 4 * lane) = o;
                    }
                }
            }
        }
        }
        }
#endif
        xcd_barrier(xbar);
#ifndef SKIP_PD
        {
            PHASE_PTRS();
            pg8::Gemm g{MIX, WOUT, NLAT, 1024, 1024}; pg8::StaticOrder S; S.init(NLAT, 1024, G, bx);
            pg8::EpiResid E{XB, XB, modl, 2};
            pg8::gemm_phase<pg8::EpiResid, pg8::StaticOrder, PG8_ALIGN, PG8_SP2>(lds, g, S, E);
        }
        {
            PHASE_IDS(); PHASE_PTRS();
            LAS float* red = (LAS float*)lds;
            for (int tile = vcu; tile < (l == NLAYER - 1 ? 0 : 256); tile += G) {
                const int rtile = tile >> 4, ctile = tile & 15;
                small_gemm<2, 4>(MIX + (size_t)(NLAT + 32 * rtile) * 1024, 1024, WOUT, [&](int c, int k) { return pg8::wt_off(64 * ctile + c, k, 16, true); }, red, lane, wave);
                __syncthreads();
                const int r = tid >> 4, c0 = (tid & 15) * 4; const int cr = 32 * rtile + r, col = 64 * ctile + c0;
                f32x4 v = {0.f, 0.f, 0.f, 0.f};
#pragma unroll
                for (int w = 0; w < 8; ++w) v += *(const LAS f32x4*)(red + ((size_t)w * 32 + r) * 64 + c0);
                const f32x4 gt = *(const f32x4*)(modl + (size_t)(2 * 6 + 2) * 1024 + col);
                const f32x4 b = *(const f32x4*)(cur_ctx + (size_t)cr * 1024 + col);
                *(f32x4*)(XSC + (size_t)cr * 1024 + col) = b + gt * v;
                __syncthreads();
            }
        }
        if (fused) { PHASE_IDS(); PHASE_PTRS();
            pg8::StaticOrder S2; S2.init(NLAT, 1024, G, bx); pg8::Unit u2; (void)S2.next(0, u2);
            panel_norm(CNT + (l * 2 + 0) * 128, u2.pm, u2.pn, vcu, XB, out, XSC, norm2_g + l * 1024, modl, 3, 4, H, false, l < NLAYER - 1, tid, lane, wave);
        }
#endif
        xcd_barrier(xbar);
        if (!fused) { { PHASE_IDS(); PHASE_PTRS(); NORM_ROWS(XB, XSC, norm2_g + l * 1024, modl, 3, 4); } xcd_barrier(xbar); }
#ifndef SKIP_PF
        for (int rep_ = 0; rep_ < REP_PF; ++rep_) { if (rep_) xcd_barrier(xbar);
        {
            PHASE_PTRS();
            const int mf = (l == NLAYER - 1) ? NLAT : MROWS;
            pg8::Gemm g{H, WUP, mf, DUP, 1024}; pg8::StaticOrder S; S.init(mf, DUP, G, bx);
            pg8::EpiUpConv E{ACT, HALO, ffn_conv_w + (size_t)l * 3 * DUP};
            pg8::gemm_phase<pg8::EpiUpConv, pg8::StaticOrder, PG8_ALIGN, PG8_SP2>(lds, g, S, E);
            if (hide_conv && l + 1 < NLAYER && bx >= f_rem) {
                PHASE_IDS(); LAS float* scr = (LAS float*)(lds + wave * 16384);
#define L_OF_(i) (l + 1)
#define I_OF_(i) (i)
                CONV_RUN((bx - f_rem) * NWAVES + wave, n_idle * NWAVES, CONV_ITEMS, L_OF_, I_OF_);
#undef L_OF_
#undef I_OF_
            }
            if (!hide_conv && l + 1 < NLAYER) { PHASE_IDS(); LAS float* scr = (LAS float*)(lds + wave * 16384);
                for (int it = gw; it < CONV_ITEMS; it += NGW) convert_item(it, l + 1, w_in, w_out, ffn_up, ffn_down, (unsigned char*)ws, scr, lane); }
        }
        }
#endif
        xcd_barrier(xbar);
#ifndef SKIP_PG
        { PHASE_IDS(); PHASE_PTRS();
            const float* cw = ffn_conv_w + (size_t)l * 3 * DUP;
            for (int tk = gw; tk < 11 * 2 * ((l == NLAYER - 1 ? NLAT : MROWS) / 128 - 1); tk += NGW) {
                const int task = tk / 11, it = tk - 11 * task; const int S = 1 + (task >> 1), which = task & 1, R = 128 * S;
                const bool boundary = R < NLAT ? ((R & (SEQL - 1)) == 0) : (((R - NLAT) & (CTXL - 1)) == 0);
                if (boundary) continue;
                const float* hp = HALO + (size_t)((S - 1) * 4 + 2 + which) * DUP;
                const int row = R - 1 + which;
                {
                    const int c = 4 * (lane + 64 * it);
                    const f32x4 ap = *(const f32x4*)(hp + c), am = *(const f32x4*)(hp + DUP + c), an = *(const f32x4*)(hp + 2 * DUP + c);
                    const f32x4 gp = *(const f32x4*)(hp + DFF + c), gmv = *(const f32x4*)(hp + DUP + DFF + c), gn = *(const f32x4*)(hp + 2 * DUP + DFF + c);
                    const f32x4 wa0 = *(const f32x4*)(cw + c), wa1 = *(const f32x4*)(cw + DUP + c), wa2 = *(const f32x4*)(cw + 2 * DUP + c);
                    const f32x4 wg0 = *(const f32x4*)(cw + DFF + c), wg1 = *(const f32x4*)(cw + DUP + DFF + c), wg2 = *(const f32x4*)(cw + 2 * DUP + DFF + c);
                    const f32x4 ca = wa0 * ap + wa1 * am + wa2 * an, cg = wg0 * gp + wg1 * gmv + wg2 * gn;
                    v2u o; o.x = pk2(silu_f(cg.x) * ca.x, silu_f(cg.y) * ca.y); o.y = pk2(silu_f(cg.z) * ca.z, silu_f(cg.w) * ca.w);
                    *(v2u*)(ACT + (size_t)row * DFF + c) = o;
                }
            }
        }
#endif
        xcd_barrier(xbar);
#ifndef SKIP_PH
        {
            PHASE_PTRS();
            pg8::Gemm g{ACT, WDN, NLAT, 1024, DFF}; pg8::StaticOrder S; S.init(NLAT, 1024, G, bx);
            pg8::EpiResid E{XB, XB, modl, 5};
            pg8::gemm_phase<pg8::EpiResid, pg8::StaticOrder, PG8_ALIGN, PG8_SP2>(lds, g, S, E);
        }
        {
            PHASE_IDS(); PHASE_PTRS();
            LAS float* red = (LAS float*)lds;
            for (int tile = vcu; tile < (l == NLAYER - 1 ? 0 : 256); tile += G) {
                const int rtile = tile >> 4, ctile = tile & 15;
                small_gemm<2, 11>(ACT + (size_t)(NLAT + 32 * rtile) * 2816, 2816, WDN, [&](int c, int k) { return pg8::wt_off(64 * ctile + c, k, 44, true); }, red, lane, wave);
                __syncthreads();
                const int r = tid >> 4, c0 = (tid & 15) * 4; const int cr = 32 * rtile + r, col = 64 * ctile + c0;
                f32x4 v = {0.f, 0.f, 0.f, 0.f};
#pragma unroll
                for (int w = 0; w < 8; ++w) v += *(const LAS f32x4*)(red + ((size_t)w * 32 + r) * 64 + c0);
                const f32x4 gt = *(const f32x4*)(modl + (size_t)(2 * 6 + 5) * 1024 + col);
                const f32x4 b = *(const f32x4*)(XSC + (size_t)cr * 1024 + col);
                *(f32x4*)(XSC + (size_t)cr * 1024 + col) = b + gt * v;
                __syncthreads();
            }
        }
        if (fused) { PHASE_IDS(); PHASE_PTRS();
            pg8::StaticOrder S2; S2.init(NLAT, 1024, G, bx); pg8::Unit u2; (void)S2.next(0, u2);
            const bool fin = (l == NLAYER - 1); const int ln = fin ? l : l + 1;
            panel_norm(CNT + (l * 2 + 1) * 128, u2.pm, u2.pn, vcu, XB, out, XSC, fin ? final_g : norm1_g + ln * 1024, MODV + (size_t)ln * 3 * 6144, 0, 1, H, fin, !fin, tid, lane, wave);
        }
#endif
        if (fused && l == NLAYER - 1) break;
        xcd_barrier(xbar);
        if (!fused) { PHASE_IDS(); PHASE_PTRS();
            if (l < NLAYER - 1) { NORM_ROWS(XB, XSC, norm1_g + (l + 1) * 1024, MODV + (size_t)(l + 1) * 3 * 6144, 0, 1); }
            else {
                for (int m = gw; m < NLAT; m += NGW) { f32x4 va[4]; norm_load_bf(XB + (size_t)m * 1024, lane, va); final_finish(va, final_g, out + (size_t)m * 1024, lane); }
            }
            if (l < NLAYER - 1) xcd_barrier(xbar);
        }
    }
}

extern "C" void kernel_launch(void* const* d_in, const int* in_sizes, int n_in, void* d_out, int out_size, void* d_ws, size_t ws_size, hipStream_t stream) {
    static int grid = 0;
    if (grid == 0) {
        if (n_in != 19 || out_size != NLAT * DMOD || ws_size < WS_END) { fprintf(stderr, "kernel_launch: unexpected shapes (n_in %d out %d ws %zu need %zu)\n", n_in, out_size, ws_size, (size_t)WS_END); grid = -1; return; }
        int dev = 0, cus = 0, per_cu = 0;
        hipGetDevice(&dev); hipDeviceGetAttribute(&cus, hipDeviceAttributeMultiprocessorCount, dev);
        if (hipFuncSetAttribute((const void*)fwd_megakernel, hipFuncAttributeMaxDynamicSharedMemorySize, LDS_BYTES) != hipSuccess) { fprintf(stderr, "kernel_launch: hipFuncSetAttribute failed\n"); grid = -1; return; }
        if (hipOccupancyMaxActiveBlocksPerMultiprocessor(&per_cu, (const void*)fwd_megakernel, NTHR, LDS_BYTES) != hipSuccess || per_cu < 1) { fprintf(stderr, "kernel_launch: occupancy query says %d\n", per_cu); per_cu = 1; }
        (void)hipGetLastError();
        grid = cus;
    }
    if (grid < 0) return;
    if (hipMemsetAsync((char*)d_ws + WS_BAR, 0, WS_CNT + 4096 - WS_BAR, stream) != hipSuccess) { fprintf(stderr, "kernel_launch: hipMemsetAsync failed\n"); return; }
    Args a{};
    for (int i = 0; i < 19; ++i) a.in[i] = (const float*)d_in[i];
    a.out = (float*)d_out; a.ws = (unsigned char*)d_ws;
    void* kargs[] = {&a};
    hipError_t e = hipLaunchCooperativeKernel((const void*)fwd_megakernel, dim3(grid), dim3(NTHR), kargs, LDS_BYTES, stream);
    if (e != hipSuccess) fprintf(stderr, "kernel_launch: cooperative launch failed: %s (grid %d)\n", hipGetErrorString(e), grid);
}
```
